# Optimizing an MI355X kernel written in HIP

```python
import math
import jax, jax.numpy as jnp
from jax import lax
import numpy as np

D_MODEL = 1024
BATCH = 4
SEQ = 8192
DEPTH = 2

GLA_HEADS = 4
GLA_DV = 96
GLA_DK = 48
GLA_QK = GLA_HEADS * GLA_DK
GLA_WIDTH = GLA_HEADS * GLA_DV
GLA_RANK = 16
GLA_TAU = 16.0
GLA_CHUNK = 64
DSA_HEADS = 4
DSA_HEAD_DIM = 64
DSA_WIDTH = DSA_HEADS * DSA_HEAD_DIM
DSA_IDX_HEADS = 8
DSA_IDX_DIM = 32
DSA_TOPK = 256
DSA_QBLOCK = 128
S5_GROUPS = 24
S5_GROUP_CH = 16
S5_STATE = 64
S5_WIDTH = S5_GROUPS * S5_GROUP_CH
D_MIX = GLA_WIDTH + DSA_WIDTH + S5_WIDTH
IN_SIZES = (GLA_QK, GLA_QK, GLA_WIDTH, GLA_RANK, GLA_WIDTH,
            DSA_WIDTH, DSA_WIDTH, DSA_WIDTH, DSA_IDX_HEADS * DSA_IDX_DIM, DSA_IDX_DIM, DSA_IDX_HEADS,
            S5_WIDTH)
D_IN = 2616
MOE_GROUPS = 4
MOE_EXPERTS_PER_GROUP = 8
MOE_EXPERTS = MOE_GROUPS * MOE_EXPERTS_PER_GROUP
MOE_TOPK = 2
MOE_HIDDEN = 512
MOE_BLOCK = 128
RMS_EPS = 1e-6

kernel_name = 'hybrid_gla_dsa_s5_hier_moe_block'


def rms_norm(x, g):
    xf = x.astype(jnp.float32)
    y = xf * lax.rsqrt(jnp.mean(xf * xf, axis=-1, keepdims=True) + RMS_EPS)
    return (y * g.astype(jnp.float32)).astype(x.dtype)


def gla_mixer(q, k, v, lr, r, gate_w, gate_b, norm_g):
    B, L, _ = q.shape
    n = L // GLA_CHUNK
    f32 = jnp.float32
    g = jax.nn.log_sigmoid((lr @ gate_w + gate_b).astype(f32)) / GLA_TAU

    def heads(t, d):
        return t.astype(f32).reshape(B, n, GLA_CHUNK, GLA_HEADS, d).transpose(0, 3, 1, 2, 4)

    qh = heads(q, GLA_DK) * GLA_DK ** -0.5
    kh = heads(k, GLA_DK)
    vh = heads(v, GLA_DV)
    bcum = jnp.cumsum(heads(g, GLA_DK), axis=3)
    blast = bcum[:, :, :, -1:, :]
    q_dec = qh * jnp.exp(bcum)
    causal = jnp.tril(jnp.ones((GLA_CHUNK, GLA_CHUNK), dtype=bool))
    att = jnp.einsum('bhncd,bhnsd->bhncs', q_dec, kh * jnp.exp(-bcum))
    att = jnp.where(causal, att, 0.0)
    o_intra = jnp.einsum('bhncs,bhnse->bhnce', att, vh)
    upd = jnp.einsum('bhncd,bhnce->bhnde', kh * jnp.exp(blast - bcum), vh)
    decay = jnp.exp(blast[:, :, :, 0, :])

    def step(S, inp):
        dec, u = inp
        return dec[..., None] * S + u, S

    S0 = jnp.zeros((B, GLA_HEADS, GLA_DK, GLA_DV), f32)
    _, S_in = lax.scan(step, S0, (jnp.moveaxis(decay, 2, 0), jnp.moveaxis(upd, 2, 0)))
    S_in = jnp.moveaxis(S_in, 0, 2)
    o = o_intra + jnp.einsum('bhncd,bhnde->bhnce', q_dec, S_in)
    o = o.transpose(0, 2, 3, 1, 4).reshape(B, L, GLA_HEADS, GLA_DV)
    o = rms_norm(o, norm_g).reshape(B, L, GLA_WIDTH) * jax.nn.silu(r.astype(f32))
    return o.astype(q.dtype)


def dsa_mixer(q, k, v, iq, ik, iw, norm_g):
    B, L, _ = q.shape
    f32 = jnp.float32
    n_sel = min(DSA_TOPK, L // 4)
    nb = L // DSA_QBLOCK
    qh = q.reshape(B, L, DSA_HEADS, DSA_HEAD_DIM)
    kh = k.reshape(B, L, DSA_HEADS, DSA_HEAD_DIM)
    vh = v.reshape(B, L, DSA_HEADS, DSA_HEAD_DIM)
    iqh = iq.reshape(B, L, DSA_IDX_HEADS, DSA_IDX_DIM)
    iwh = iw.astype(f32) * DSA_IDX_HEADS ** -0.5
    ikf = ik.astype(f32)
    key_pos = jnp.arange(L)

    def blocks(t):
        return jnp.moveaxis(t.reshape((B, nb, DSA_QBLOCK) + t.shape[2:]), 1, 0)

    def one_block(inp):
        qb, iqb, iwb, qpos = inp
        logits = jnp.einsum('bqhd,bsd->bqhs', iqb.astype(f32), ikf) * DSA_IDX_DIM ** -0.5
        score = jnp.einsum('bqh,bqhs->bqs', iwb, jax.nn.relu(logits))
        admissible = key_pos[None, :] <= qpos[:, None]
        score = jnp.where(admissible[None], score, -jnp.inf)
        _, sel = lax.top_k(score, n_sel)
        valid = sel <= qpos[None, :, None]
        kg = jax.vmap(lambda kb, ib: kb[ib])(kh, sel)
        vg = jax.vmap(lambda vb, ib: vb[ib])(vh, sel)
        s = jnp.einsum('bqhd,bqkhd->bhqk', qb.astype(f32), kg.astype(f32)) * DSA_HEAD_DIM ** -0.5
        s = jnp.where(valid[:, None], s, -jnp.inf)
        p = jax.nn.softmax(s, axis=-1)
        return jnp.einsum('bhqk,bqkhd->bqhd', p, vg.astype(f32))

    qpos = jnp.arange(L).reshape(nb, DSA_QBLOCK)
    out = lax.map(one_block, (blocks(qh), blocks(iqh), blocks(iwh), qpos))
    out = jnp.moveaxis(out, 0, 1).reshape(B, L, DSA_WIDTH)
    return rms_norm(out, norm_g).astype(q.dtype)


def s5_mixer(u, a_re, a_im, log_step, b_re, b_im, c_re, c_im, d, glu_w, glu_b, norm_g):
    B, L, _ = u.shape
    f32 = jnp.float32
    ug = u.astype(f32).reshape(B, L, S5_GROUPS, S5_GROUP_CH)
    dt = jnp.exp(log_step.astype(f32))[:, None]
    ar, ai = a_re.astype(f32), a_im.astype(f32)
    mag = jnp.exp(ar * dt)
    lam_re, lam_im = mag * jnp.cos(ai * dt), mag * jnp.sin(ai * dt)
    den = ar * ar + ai * ai
    nr, ni = lam_re - 1.0, lam_im
    coef_re = (nr * ar + ni * ai) / den
    coef_im = (ni * ar - nr * ai) / den
    br, bi = b_re.astype(f32), b_im.astype(f32)
    bb_re = coef_re[..., None] * br - coef_im[..., None] * bi
    bb_im = coef_re[..., None] * bi + coef_im[..., None] * br
    x_re = jnp.einsum('blgc,gpc->blgp', ug, bb_re)
    x_im = jnp.einsum('blgc,gpc->blgp', ug, bb_im)
    a_re_t = jnp.broadcast_to(lam_re, (1, L) + lam_re.shape)
    a_im_t = jnp.broadcast_to(lam_im, (1, L) + lam_im.shape)

    def combine(e1, e2):
        a1r, a1i, x1r, x1i = e1
        a2r, a2i, x2r, x2i = e2
        return (a2r * a1r - a2i * a1i, a2r * a1i + a2i * a1r,
                a2r * x1r - a2i * x1i + x2r, a2r * x1i + a2i * x1r + x2i)

    _, _, h_re, h_im = lax.associative_scan(combine, (a_re_t, a_im_t, x_re, x_im), axis=1)
    y = (jnp.einsum('blgp,gcp->blgc', h_re, c_re.astype(f32))
         - jnp.einsum('blgp,gcp->blgc', h_im, c_im.astype(f32)))
    y = (y + d.astype(f32) * ug).reshape(B, L, S5_WIDTH)
    y = jax.nn.gelu(y)
    y = y * jax.nn.sigmoid(y @ glu_w.astype(f32) + glu_b.astype(f32))
    return rms_norm(y, norm_g).astype(u.dtype)


def token_mix(h, w_in, gla_gate_w, gla_gate_b, gla_norm_g, dsa_norm_g, s5_a_re, s5_a_im,
              s5_log_step, s5_b_re, s5_b_im, s5_c_re, s5_c_im, s5_d, s5_glu_w, s5_glu_b,
              s5_norm_g, w_out):
    proj = h @ w_in
    offsets = np.cumsum(IN_SIZES)[:-1].tolist()
    (g_q, g_k, g_v, g_lr, g_r, d_q, d_k, d_v, i_q, i_k, i_w, s_u) = jnp.split(proj, offsets, axis=-1)
    o_gla = gla_mixer(g_q, g_k, g_v, g_lr, g_r, gla_gate_w, gla_gate_b, gla_norm_g)
    o_dsa = dsa_mixer(d_q, d_k, d_v, i_q, i_k, i_w, dsa_norm_g)
    o_s5 = s5_mixer(s_u, s5_a_re, s5_a_im, s5_log_step, s5_b_re, s5_b_im, s5_c_re, s5_c_im,
                    s5_d, s5_glu_w, s5_glu_b, s5_norm_g)
    return jnp.concatenate([o_gla, o_dsa, o_s5], axis=-1) @ w_out


def hier_moe(h, wg, bg, we, be, w_gate, w_up, w_down):
    B, L, D = h.shape
    T = B * L
    f32 = jnp.float32
    xt = h.reshape(T, D)
    grp_prob = jax.nn.softmax((xt @ wg + bg).astype(f32), axis=-1)
    grp_p, grp_i = lax.top_k(grp_prob, 1)
    exp_logits = (xt @ we + be).astype(f32).reshape(T, MOE_GROUPS, MOE_EXPERTS_PER_GROUP)
    in_grp = jnp.take_along_axis(exp_logits, grp_i[:, :, None], axis=1)[:, 0]
    top_l, top_j = lax.top_k(in_grp, MOE_TOPK)
    weights = grp_p * jax.nn.softmax(top_l, axis=-1)
    expert = grp_i * MOE_EXPERTS_PER_GROUP + top_j
    N = T * MOE_TOPK
    flat_e = expert.reshape(N)
    flat_tok = jnp.repeat(jnp.arange(T), MOE_TOPK)
    flat_w = weights.reshape(N)
    order = jnp.argsort(flat_e)
    se = flat_e[order]
    tok_sorted = flat_tok[order]
    counts = jnp.bincount(flat_e, length=MOE_EXPERTS)
    padded = (counts + MOE_BLOCK - 1) // MOE_BLOCK * MOE_BLOCK
    start = jnp.cumsum(counts) - counts
    pend = jnp.cumsum(padded)
    pstart = pend - padded
    dest = pstart[se] + jnp.arange(N) - start[se]
    n_blocks = -(-N // MOE_BLOCK) + MOE_EXPERTS
    rows = jnp.zeros((n_blocks * MOE_BLOCK, D), h.dtype).at[dest].set(xt[tok_sorted])
    block_e = jnp.minimum(jnp.searchsorted(pend, jnp.arange(n_blocks) * MOE_BLOCK, side='right'),
                          MOE_EXPERTS - 1)

    def run(inp):
        xb, e = inp
        hid = jax.nn.silu(xb @ w_gate[e]) * (xb @ w_up[e])
        return hid @ w_down[e]

    out = lax.map(run, (rows.reshape(n_blocks, MOE_BLOCK, D), block_e)).reshape(-1, D)
    contrib = out[dest] * flat_w[order][:, None].astype(out.dtype)
    y = jnp.zeros((T, D), out.dtype).at[tok_sorted].add(contrib)
    return y.reshape(B, L, D)


def setup_inputs(seed: int = 0) -> dict:
    key = jax.random.key(seed)
    ks = iter(jax.random.split(key, 40))

    def nrm(shape, s):
        return jax.random.normal(next(ks), shape, jnp.float32) * s

    D = D_MODEL
    n = jnp.arange(S5_STATE, dtype=jnp.float32)
    return {
        'x': nrm((BATCH, SEQ, D), 1.0),
        'c': nrm((BATCH, D), 1.0),
        'ada_w': nrm((DEPTH, D, 6 * D), 0.5 * D ** -0.5),
        'ada_b': nrm((DEPTH, 6 * D), 0.02),
        'norm1_g': 1.0 + nrm((DEPTH, D), 0.02),
        'w_in': nrm((DEPTH, D, D_IN), D ** -0.5),
        'gla_gate_w': nrm((DEPTH, GLA_RANK, GLA_QK), GLA_RANK ** -0.5),
        'gla_gate_b': nrm((DEPTH, GLA_QK), 0.1),
        'gla_norm_g': 1.0 + nrm((DEPTH, GLA_DV), 0.02),
        'dsa_norm_g': 1.0 + nrm((DEPTH, DSA_WIDTH), 0.02),
        's5_a_re': -0.5 * (1.0 + nrm((DEPTH, S5_GROUPS, S5_STATE), 0.01)),
        's5_a_im': jnp.broadcast_to(math.pi * n, (DEPTH, S5_GROUPS, S5_STATE)),
        's5_log_step': jax.random.uniform(next(ks), (DEPTH, S5_GROUPS), jnp.float32,
                                          minval=math.log(1e-3), maxval=math.log(1e-1)),
        's5_b_re': nrm((DEPTH, S5_GROUPS, S5_STATE, S5_GROUP_CH), (2 * S5_GROUP_CH) ** -0.5),
        's5_b_im': nrm((DEPTH, S5_GROUPS, S5_STATE, S5_GROUP_CH), (2 * S5_GROUP_CH) ** -0.5),
        's5_c_re': nrm((DEPTH, S5_GROUPS, S5_GROUP_CH, S5_STATE), (2 * S5_STATE) ** -0.5),
        's5_c_im': nrm((DEPTH, S5_GROUPS, S5_GROUP_CH, S5_STATE), (2 * S5_STATE) ** -0.5),
        's5_d': nrm((DEPTH, S5_GROUPS, S5_GROUP_CH), 0.5),
        's5_glu_w': nrm((DEPTH, S5_WIDTH, S5_WIDTH), S5_WIDTH ** -0.5),
        's5_glu_b': nrm((DEPTH, S5_WIDTH), 0.02),
        's5_norm_g': 1.0 + nrm((DEPTH, S5_WIDTH), 0.02),
        'w_out': nrm((DEPTH, D_MIX, D), D_MIX ** -0.5),
        'norm2_g': 1.0 + nrm((DEPTH, D), 0.02),
        'router_grp_w': nrm((DEPTH, D, MOE_GROUPS), D ** -0.5),
        'router_grp_b': nrm((DEPTH, MOE_GROUPS), 0.01),
        'router_exp_w': nrm((DEPTH, D, MOE_EXPERTS), D ** -0.5),
        'router_exp_b': nrm((DEPTH, MOE_EXPERTS), 0.01),
        'exp_w_gate': nrm((DEPTH, MOE_EXPERTS, D, MOE_HIDDEN), D ** -0.5),
        'exp_w_up': nrm((DEPTH, MOE_EXPERTS, D, MOE_HIDDEN), D ** -0.5),
        'exp_w_down': nrm((DEPTH, MOE_EXPERTS, MOE_HIDDEN, D), MOE_HIDDEN ** -0.5),
        'final_norm_g': 1.0 + nrm((D,), 0.02),
    }


def reference(x, c, ada_w, ada_b, norm1_g, w_in, gla_gate_w, gla_gate_b, gla_norm_g, dsa_norm_g,
              s5_a_re, s5_a_im, s5_log_step, s5_b_re, s5_b_im, s5_c_re, s5_c_im, s5_d, s5_glu_w,
              s5_glu_b, s5_norm_g, w_out, norm2_g, router_grp_w, router_grp_b, router_exp_w,
              router_exp_b, exp_w_gate, exp_w_up, exp_w_down, final_norm_g):
    cond = jax.nn.silu(c)
    for l in range(DEPTH):
        mod = (cond @ ada_w[l] + ada_b[l])[:, None, :]
        sh1, sc1, gt1, sh2, sc2, gt2 = jnp.split(mod, 6, axis=-1)
        h = rms_norm(x, norm1_g[l]) * (1.0 + sc1) + sh1
        x = x + gt1 * token_mix(h, w_in[l], gla_gate_w[l], gla_gate_b[l], gla_norm_g[l],
                                dsa_norm_g[l], s5_a_re[l], s5_a_im[l], s5_log_step[l],
                                s5_b_re[l], s5_b_im[l], s5_c_re[l], s5_c_im[l], s5_d[l],
                                s5_glu_w[l], s5_glu_b[l], s5_norm_g[l], w_out[l])
        h = rms_norm(x, norm2_g[l]) * (1.0 + sc2) + sh2
        x = x + gt2 * hier_moe(h, router_grp_w[l], router_grp_b[l], router_exp_w[l],
                               router_exp_b[l], exp_w_gate[l], exp_w_up[l], exp_w_down[l])
    return rms_norm(x, final_norm_g)
```

```cpp
#include <hip/hip_runtime.h>
#include <hip/hip_cooperative_groups.h>
#include <cstdio>
#include <cstdint>
#include <cmath>
#include <cstring>
namespace cg = cooperative_groups;
namespace pg8 {
#define PG8_LAS __attribute__((address_space(3)))
typedef unsigned short bf16_t;
typedef short bf16x8 __attribute__((ext_vector_type(8)));
typedef float f32x4 __attribute__((ext_vector_type(4)));
typedef unsigned u32x4 __attribute__((ext_vector_type(4)));
constexpr int BM = 256, BK = 64, HALF = 128, HTB = HALF * BK * 2  , STAGE_BYTES = 8 * HTB, NXCD = 8, WGM = 8;

__host__ __device__ __forceinline__ int lds_byte(int r, int c) { const int st = (r >> 4) * 2 + (c >> 5), rr = r & 15, cc = c & 31, ob = rr * 64 + cc * 2; return st * 1024 + (ob ^ (((ob >> 9) & 1) << 5)); }
__host__ __device__ __forceinline__ void stage_rc(int b, int& R, int& C) { const int st = b / 1024, sb = b % 1024, swz = sb ^ (((sb >> 9) & 1) << 5); R = (st >> 1) * 16 + swz / 64; C = (st & 1) * 32 + (swz % 64) / 2; }
__host__ __device__ __forceinline__ int perm32(int rho) { const int n = rho >> 4, i = rho & 15; return 8 * (i >> 2) + 4 * n + (i & 3); }

struct Unit { int pm, pn; long boff; };
struct Gemm { const bf16_t* A; const bf16_t* Bt; int M, N, K; const int* tok; };

struct StaticOrder {
    int nM, nN, nwg, G, c;
    __host__ __device__ void init(int M, int N, int G_, int c_) { nM = M / BM; nN = N / BM; nwg = nM * nN; G = G_; c = c_; }
    __host__ __device__ bool next(int i, Unit& u) const {
        const long L = (long)i * G + c; if (L >= nwg) return false;
        int wgid = (int)L; { const int q = nwg / NXCD, r = nwg % NXCD, xcd = wgid % NXCD, off = wgid / NXCD; wgid = (xcd < r ? xcd * (q + 1) : r * (q + 1) + (xcd - r) * q) + off; }
        const int nig = WGM * nN, gid = wgid / nig, fm = gid * WGM, gsz = (nM - fm) < WGM ? (nM - fm) : WGM;
        u.pm = fm + ((wgid % nig) % gsz); u.pn = (wgid % nig) / gsz; u.boff = 0; return true;
    }
    __device__ __forceinline__ void a_ready(const Unit&) const {}
    __device__ __forceinline__ void done(const Unit&) const {}
};

__device__ __forceinline__ unsigned cvt_pk_bf16(float lo, float hi) { unsigned r; asm volatile("v_cvt_pk_bf16_f32 %0, %1, %2" : "=v"(r) : "v"(lo), "v"(hi)); return r; }
typedef float f32x2 __attribute__((ext_vector_type(2)));
__device__ __forceinline__ f32x2 gelu_pk(f32x2 v) {
    const f32x2 av = __builtin_elementwise_abs(v), d = av * 0.2316418882f + 1.0f;
    f32x2 t; t.x = __builtin_amdgcn_rcpf(d.x); t.y = __builtin_amdgcn_rcpf(d.y);
    f32x2 q = t * 0.5307027145f + (-0.7265760135f); q = q * t + 0.7107068705f; q = q * t + (-0.142248368f); q = q * t + 0.127414796f; q = q * t;
    const f32x2 s = (v * v) * (-0.72134752044f);
    f32x2 e; e.x = __builtin_amdgcn_exp2f(s.x); e.y = __builtin_amdgcn_exp2f(s.y);
    const f32x2 m = v * (q * e), r = v - m;
    f32x2 o; o.x = v.x < 0.f ? m.x : r.x; o.y = v.y < 0.f ? m.y : r.y; return o;
}

template <int ACT  > struct EpiBf16 {
    static constexpr bool PERM = true, AFTER_DRAIN = false; static_assert(ACT == 0 || ACT == 1, "EpiBf16: ACT is 0 (none) or 1 (gelu_pk)");
    bf16_t* O; int ldc; const float* bias; int split_cols; size_t split_stride; float scale0;
    __device__ __forceinline__ void operator()(const f32x4 (&acc)[2][2][4][2], const Unit& u, int wr, int wc, int fr, int fq) const {
        const int row0 = u.pm * BM + wr * 64 + fr; int colt = u.pn * BM; bf16_t* base = O;
        float sc = 1.f; if (split_cols) { const int t = colt / split_cols; base += (size_t)t * split_stride; colt -= t * split_cols; if (t == 0) sc = scale0; }
        const int col0 = colt + wc * 32 + 8 * fq, bcol0 = u.pn * BM + wc * 32 + 8 * fq;
        f32x4 bv[2][2];
#pragma unroll
        for (int bj = 0; bj < 2; ++bj)
#pragma unroll
            for (int n = 0; n < 2; ++n) bv[bj][n] = bias ? *(const f32x4*)(bias + bcol0 + bj * HALF + 4 * n) : (f32x4){0.f, 0.f, 0.f, 0.f};
#pragma unroll
        for (int ai = 0; ai < 2; ++ai)
#pragma unroll
            for (int m = 0; m < 4; ++m) { bf16_t* rowp = base + (size_t)(row0 + ai * HALF + m * 16) * ldc + col0;
#pragma unroll
                for (int bj = 0; bj < 2; ++bj) { f32x4 v0 = acc[ai][bj][m][0] + bv[bj][0], v1 = acc[ai][bj][m][1] + bv[bj][1];
                    if (ACT == 1) { f32x2 a = gelu_pk((f32x2){v0[0], v0[1]}), b = gelu_pk((f32x2){v0[2], v0[3]}), c = gelu_pk((f32x2){v1[0], v1[1]}), d = gelu_pk((f32x2){v1[2], v1[3]});
                        v0 = (f32x4){a.x, a.y, b.x, b.y}; v1 = (f32x4){c.x, c.y, d.x, d.y}; }
                    v0 = v0 * sc; v1 = v1 * sc; u32x4 w; w.x = cvt_pk_bf16(v0[0], v0[1]); w.y = cvt_pk_bf16(v0[2], v0[3]); w.z = cvt_pk_bf16(v1[0], v1[1]); w.w = cvt_pk_bf16(v1[2], v1[3]);
                    *(u32x4*)(rowp + bj * HALF) = w; } }
    }
};

template <class Epi, class Sched, bool ALIGN_EPI = false, bool SP2 = false, bool GATHER = false>
__device__ __forceinline__ void gemm_phase(PG8_LAS unsigned char* lds, const Gemm g, const Sched& S, const Epi& E, const int tid) {
    const int wid = __builtin_amdgcn_readfirstlane(tid >> 6), lane = tid & 63, wr = wid >> 2, wc = wid & 3, fr = lane & 15, fq = lane >> 4;
    const int K = g.K, nt = K / BK;
    unsigned voffA[2], voffB[2];
#pragma unroll
    for (int i = 0; i < 2; ++i) { int R, C; stage_rc(tid * 16 + i * 8192, R, C); const int Rb = Epi::PERM ? ((R & ~31) + perm32(R & 31)) : R;
        voffA[i] = (unsigned)(R * K + C) * 2u; voffB[i] = (unsigned)(Rb * K + C) * 2u; }
    const size_t kstep = (size_t)(BK * 2);
    const size_t hstep = (size_t)HALF * K * 2;
    const size_t tstep = 2 * hstep;
    const unsigned ldsw = (unsigned)wid * 1024u;
    const int aoff = lds_byte(wr * 64 + fr, fq * 8), boff = lds_byte(wc * 32 + fr, fq * 8);
#define PG8_SA(b, h) (((b) * 2 + (h)) * HTB)
#define PG8_SB(b, h) ((4 + (b) * 2 + (h)) * HTB)
#define PG8_STAGE(bufoff, gbase, voff) do { _Pragma("unroll") for (int _i = 0; _i < 2; ++_i) \
        __builtin_amdgcn_global_load_lds((const unsigned*)((const char*)(gbase) + (voff)[_i]), (PG8_LAS unsigned*)(lds + (bufoff) + ldsw + _i * 8192), 16, 0, 0); } while (0)
    static_assert(!GATHER || SP2, "gather is wired into the SP2 loop only");
    unsigned gc00 = 0u, gc01 = 0u, gc10 = 0u, gc11 = 0u, gn00 = 0u, gn01 = 0u, gn10 = 0u, gn11 = 0u;
#define PG8_GOFF(u_, o00, o01, o10, o11) do { int R0_, C0_, R1_, C1_; stage_rc(tid * 16, R0_, C0_); stage_rc(tid * 16 + 8192, R1_, C1_); const int* tp_ = g.tok + (u_).pm * 256; \
        o00 = (unsigned)(tp_[R0_] * K + C0_) * 2u; o01 = (unsigned)(tp_[R1_] * K + C1_) * 2u; o10 = (unsigned)(tp_[HALF + R0_] * K + C0_) * 2u; o11 = (unsigned)(tp_[HALF + R1_] * K + C1_) * 2u; } while (0)
#define PG8_STAGE2(bufoff, gbase, v0_, v1_) do { \
        __builtin_amdgcn_global_load_lds((const unsigned*)((const char*)(gbase) + (v0_)), (PG8_LAS unsigned*)(lds + (bufoff) + ldsw), 16, 0, 0); \
        __builtin_amdgcn_global_load_lds((const unsigned*)((const char*)(gbase) + (v1_)), (PG8_LAS unsigned*)(lds + (bufoff) + ldsw + 8192), 16, 0, 0); } while (0)
#define PG8_STAGE_A(bufoff, dense_ptr, kb_, h_, nx_) do { if constexpr (GATHER) { const char* gb_ = (const char*)g.A + (kb_); \
            if ((h_) == 0) PG8_STAGE2(bufoff, gb_, (nx_) ? gn00 : gc00, (nx_) ? gn01 : gc01); else PG8_STAGE2(bufoff, gb_, (nx_) ? gn10 : gc10, (nx_) ? gn11 : gc11); } \
        else PG8_STAGE(bufoff, dense_ptr, voffA); } while (0)
#define PG8_LDA(dst, b, h) do { _Pragma("unroll") for (int m = 0; m < 4; ++m) _Pragma("unroll") for (int k = 0; k < 2; ++k) dst[m][k] = *(const PG8_LAS bf16x8*)(lds + PG8_SA(b, h) + aoff + m * 2048 + k * 1024); } while (0)
#define PG8_LDB(dst, b, h) do { _Pragma("unroll") for (int n = 0; n < 2; ++n) _Pragma("unroll") for (int k = 0; k < 2; ++k) dst[n][k] = *(const PG8_LAS bf16x8*)(lds + PG8_SB(b, h) + boff + n * 2048 + k * 1024); } while (0)
#define PG8_MMA(ai, bj, At, Bt) do { __builtin_amdgcn_s_setprio(1); _Pragma("unroll") for (int m = 0; m < 4; ++m) _Pragma("unroll") for (int n = 0; n < 2; ++n) _Pragma("unroll") for (int k = 0; k < 2; ++k) \
        acc[ai][bj][m][n] = __builtin_amdgcn_mfma_f32_16x16x32_bf16(Bt[n][k], At[m][k], acc[ai][bj][m][n], 0, 0, 0); __builtin_amdgcn_s_setprio(0); } while (0)
#define PG8_WAIT_V(n) asm volatile("s_waitcnt vmcnt(" #n ")" ::: "memory")
#define PG8_WAIT_L(n) asm volatile("s_waitcnt lgkmcnt(" #n ")" ::: "memory")
#define PG8_BAR __builtin_amdgcn_s_barrier()
#define PG8_SCHED __builtin_amdgcn_sched_barrier(0)
    Unit cur, nxt; int ui = 0;
    if (!S.next(0, cur)) return;
    f32x4 acc[2][2][4][2];
#pragma unroll
    for (int a = 0; a < 2; ++a)
#pragma unroll
        for (int b = 0; b < 2; ++b)
#pragma unroll
            for (int m = 0; m < 4; ++m)
#pragma unroll
                for (int n = 0; n < 2; ++n) acc[a][b][m][n] = (f32x4){0.f, 0.f, 0.f, 0.f};
    bf16x8 At[4][2], B0[2][2], B1[2][2];
    const char* cA = (const char*)g.A + (size_t)cur.pm * tstep; const char* cB = (const char*)g.Bt + cur.boff + (size_t)cur.pn * tstep;
    S.a_ready(cur);
    if constexpr (GATHER) PG8_GOFF(cur, gc00, gc01, gc10, gc11);
    if constexpr (SP2) {
        PG8_STAGE(PG8_SB(0, 0), cB, voffB); PG8_STAGE(PG8_SB(0, 1), cB + hstep, voffB); PG8_STAGE_A(PG8_SA(0, 0), cA, (size_t)0, 0, false); PG8_STAGE_A(PG8_SA(0, 1), cA + hstep, (size_t)0, 1, false);
        if (wr == 1) PG8_BAR;
        PG8_WAIT_V(2); PG8_BAR;
        PG8_STAGE(PG8_SB(1, 0), cB + kstep, voffB); PG8_STAGE_A(PG8_SA(1, 0), cA + kstep, kstep, 0, false); PG8_STAGE(PG8_SB(1, 1), cB + hstep + kstep, voffB);
        PG8_WAIT_V(6); PG8_BAR;
    } else {
        PG8_STAGE(PG8_SB(0, 0), cB, voffB); PG8_STAGE(PG8_SA(0, 0), cA, voffA); PG8_STAGE(PG8_SB(0, 1), cB + hstep, voffB); PG8_STAGE(PG8_SA(0, 1), cA + hstep, voffA);
        if (wr == 1) PG8_BAR;
        PG8_WAIT_V(4); PG8_BAR;
        PG8_STAGE(PG8_SB(1, 0), cB + kstep, voffB); PG8_STAGE(PG8_SA(1, 0), cA + kstep, voffA); PG8_STAGE(PG8_SB(1, 1), cB + hstep + kstep, voffB);
        PG8_WAIT_V(6); PG8_BAR;
    }
    for (;;) {
        const bool has_next = S.next(ui + 1, nxt);
        if constexpr (GATHER) { if (has_next) PG8_GOFF(nxt, gn00, gn01, gn10, gn11); else { gn00 = gc00; gn01 = gc01; gn10 = gc10; gn11 = gc11; } }
        const char* nA = has_next ? (const char*)g.A + (size_t)nxt.pm * tstep : cA; const char* nB = has_next ? (const char*)g.Bt + nxt.boff + (size_t)nxt.pn * tstep : cB;
        for (int t = 0; t < nt; t += 2) {
            const bool last = (t == nt - 2);
            const char* a1 = cA + (size_t)(t + 1) * kstep;
            const char* a2 = last ? nA : cA + (size_t)(t + 2) * kstep; const char* b2 = last ? nB : cB + (size_t)(t + 2) * kstep;
            const char* a3 = a2 + kstep; const char* b3 = b2 + kstep;
            const size_t k1 = (size_t)(t + 1) * kstep, k2 = last ? (size_t)0 : (size_t)(t + 2) * kstep, k3 = k2 + kstep;
            if (last && has_next) S.a_ready(nxt);
            if constexpr (SP2) {
            PG8_LDB(B0, 0, 0); PG8_LDB(B1, 0, 1); PG8_SCHED; PG8_LDA(At, 0, 0); PG8_STAGE_A(PG8_SA(1, 1), a1 + hstep, k1, 1, false);
            PG8_WAIT_V(8); PG8_WAIT_L(0); PG8_BAR; PG8_MMA(0, 0, At, B0); PG8_MMA(0, 1, At, B1); PG8_BAR; PG8_SCHED;
            PG8_LDA(At, 0, 1); PG8_STAGE(PG8_SB(0, 0), b2, voffB); PG8_STAGE(PG8_SB(0, 1), b2 + hstep, voffB); PG8_STAGE_A(PG8_SA(0, 0), a2, k2, 0, last);
            PG8_WAIT_V(8); PG8_WAIT_L(0); PG8_BAR; PG8_MMA(1, 0, At, B0); PG8_MMA(1, 1, At, B1); PG8_BAR; PG8_SCHED;
            PG8_LDB(B0, 1, 0); PG8_LDB(B1, 1, 1); PG8_SCHED; PG8_LDA(At, 1, 0); PG8_STAGE_A(PG8_SA(0, 1), a2 + hstep, k2, 1, last);
            PG8_WAIT_V(8); PG8_WAIT_L(0); PG8_BAR; PG8_MMA(0, 0, At, B0); PG8_MMA(0, 1, At, B1); PG8_BAR; PG8_SCHED;
            PG8_LDA(At, 1, 1); PG8_STAGE(PG8_SB(1, 0), b3, voffB); PG8_STAGE(PG8_SB(1, 1), b3 + hstep, voffB); PG8_STAGE_A(PG8_SA(1, 0), a3, k3, 0, last);
            PG8_WAIT_V(8); PG8_WAIT_L(0); PG8_BAR; PG8_MMA(1, 0, At, B0); PG8_MMA(1, 1, At, B1); PG8_BAR; PG8_SCHED;
            } else {
            PG8_LDB(B0, 0, 0); PG8_SCHED; PG8_LDA(At, 0, 0); PG8_STAGE(PG8_SA(1, 1), a1 + hstep, voffA);
            PG8_WAIT_L(8); PG8_BAR; PG8_WAIT_L(0); PG8_MMA(0, 0, At, B0); PG8_BAR; PG8_SCHED;
            PG8_LDB(B1, 0, 1); PG8_STAGE(PG8_SB(0, 0), b2, voffB);
            PG8_BAR; PG8_WAIT_L(0); PG8_MMA(0, 1, At, B1); PG8_BAR;
            PG8_LDA(At, 0, 1); PG8_STAGE(PG8_SA(0, 0), a2, voffA);
            PG8_BAR; PG8_WAIT_L(0); PG8_MMA(1, 0, At, B0); PG8_BAR; PG8_SCHED;
            PG8_STAGE(PG8_SB(0, 1), b2 + hstep, voffB);
            PG8_WAIT_V(6); PG8_BAR; PG8_MMA(1, 1, At, B1); PG8_BAR;
            PG8_LDB(B0, 1, 0); PG8_SCHED; PG8_LDA(At, 1, 0); PG8_STAGE(PG8_SA(0, 1), a2 + hstep, voffA);
            PG8_WAIT_L(8); PG8_BAR; PG8_WAIT_L(0); PG8_MMA(0, 0, At, B0); PG8_BAR; PG8_SCHED;
            PG8_LDB(B1, 1, 1); PG8_STAGE(PG8_SB(1, 0), b3, voffB);
            PG8_BAR; PG8_WAIT_L(0); PG8_MMA(0, 1, At, B1); PG8_BAR;
            PG8_LDA(At, 1, 1); PG8_STAGE(PG8_SA(1, 0), a3, voffA);
            PG8_BAR; PG8_WAIT_L(0); PG8_MMA(1, 0, At, B0); PG8_BAR; PG8_SCHED;
            PG8_STAGE(PG8_SB(1, 1), b3 + hstep, voffB);
            PG8_WAIT_V(6); PG8_BAR; PG8_MMA(1, 1, At, B1); PG8_BAR;
            }
        }
        if constexpr (ALIGN_EPI) { if (wr == 0) PG8_BAR; }
        if constexpr (!Epi::AFTER_DRAIN) { E(acc, cur, wr, wc, fr, fq); S.done(cur); }
        if (!has_next) break;
#pragma unroll
        for (int a = 0; a < 2; ++a)
#pragma unroll
            for (int b = 0; b < 2; ++b)
#pragma unroll
                for (int m = 0; m < 4; ++m)
#pragma unroll
                    for (int n = 0; n < 2; ++n) acc[a][b][m][n] = (f32x4){0.f, 0.f, 0.f, 0.f};
        cur = nxt; cA = nA; cB = nB; ++ui; gc00 = gn00; gc01 = gn01; gc10 = gn10; gc11 = gn11;
        if constexpr (ALIGN_EPI) { if (wr == 1) PG8_BAR; }
    }
    PG8_WAIT_V(0);
    if constexpr (!ALIGN_EPI) { if (wr == 0) PG8_BAR; }
    PG8_BAR;
    if constexpr (Epi::AFTER_DRAIN) { E.fused(acc, cur, wr, wc, fr, fq, lds, wid, lane); S.done(cur); }
#undef PG8_SA
#undef PG8_SB
#undef PG8_STAGE
#undef PG8_STAGE2
#undef PG8_STAGE_A
#undef PG8_GOFF
#undef PG8_LDA
#undef PG8_LDB
#undef PG8_MMA
#undef PG8_WAIT_V
#undef PG8_WAIT_L
#undef PG8_BAR
#undef PG8_SCHED
}
}

namespace {
typedef unsigned short bf16_t;
typedef float f32x4 __attribute__((ext_vector_type(4)));
typedef unsigned u32x4 __attribute__((ext_vector_type(4)));
typedef unsigned u32x2 __attribute__((ext_vector_type(2)));
#define LAS __attribute__((address_space(3)))

constexpr int T = 32768, L = 8192, NB = 4, D = 1024, DIN = 2616, PL = 2816;
constexpr int OQ = 0, OKK = 192, OV = 384, OLR = 768, ORR = 784, DQ = 1168, DK = 1424, DV = 1680, IQ = 1936, IK = 2192, IW = 2224, SU = 2232;
constexpr int NE = 32, MAXTILES = 288, NWAVES = 8;

constexpr size_t OFF_CTL = 0;
constexpr size_t OFF_MOD = 64 * 1024;
constexpr size_t OFF_CNT = 320 * 1024;
constexpr size_t OFF_EID = 384 * 1024;
constexpr size_t OFF_EW = OFF_EID + (size_t)T * 8;
constexpr size_t OFF_SLOT = OFF_EW + (size_t)T * 8;
constexpr size_t OFF_POS = OFF_SLOT + (size_t)T * 8;
constexpr size_t OFF_TOK = OFF_POS + (size_t)T * 8;
constexpr size_t OFF_W = 2 * 1024 * 1024;
constexpr size_t W_WIN = 0;
constexpr size_t W_WOUT = W_WIN + (size_t)2 * PL * D * 2;
constexpr size_t W_GLU = W_WOUT + (size_t)2 * D * D * 2;
constexpr size_t W_EGU = W_GLU + (size_t)2 * 384 * 384 * 2;
constexpr size_t W_EDN = W_EGU + (size_t)NE * 1024 * 1024 * 2;
constexpr size_t W_BYTES = W_EDN + (size_t)NE * 1024 * 512 * 2;
constexpr size_t OFF_HN = OFF_W + W_BYTES;
constexpr size_t OFF_C = OFF_HN + (size_t)T * D * 2;
constexpr size_t C_BYTES = (size_t)T * PL * 2;
constexpr size_t OFF_D = OFF_C + C_BYTES;
constexpr size_t D_BYTES = (size_t)MAXTILES * 256 * 1024 * 2;
constexpr size_t D_Y = (size_t)T * D * 2;
constexpr size_t OFF_E = OFF_D + D_BYTES;
constexpr size_t E_UPD = 0;
constexpr size_t E_DEC = E_UPD + (size_t)2048 * 4608 * 4;
constexpr size_t E_MASK = E_DEC + (size_t)2048 * 48 * 4;
constexpr size_t E_S5E = E_MASK + (size_t)T * 128 * 8;
constexpr size_t E_IKC = E_S5E + (size_t)4 * 24 * 128 * 64 * 2 * 4;
constexpr size_t E_BYTES = 78643200 + 2097152;
static_assert(E_IKC + (size_t)T * 32 * 2 <= E_BYTES, "E scratch overflow");
static_assert((size_t)MAXTILES * 256 * 512 * 2 <= E_BYTES, "HID overflow");
static_assert((size_t)MAXTILES * 256 * 1024 * 2 <= C_BYTES, "ROWS overflow");
static_assert(D_Y + (size_t)T * 384 * 4 <= D_BYTES, "Y overflow");
constexpr size_t WS_NEED = OFF_E + E_BYTES;

__device__ __forceinline__ float bf2f(bf16_t v) { return __uint_as_float((unsigned)v << 16); }
__device__ __forceinline__ unsigned pk2(float lo, float hi) { unsigned r; asm("v_cvt_pk_bf16_f32 %0, %1, %2" : "=v"(r) : "v"(lo), "v"(hi)); return r; }
__device__ __forceinline__ unsigned f2bf(float f) { return pk2(f, 0.f) & 0xffffu; }
__device__ __forceinline__ float4 ld4bf(const bf16_t* p) { const u32x2 w = *(const u32x2*)p; return make_float4(__uint_as_float(w.x << 16), __uint_as_float(w.x & 0xffff0000u), __uint_as_float(w.y << 16), __uint_as_float(w.y & 0xffff0000u)); }
__device__ __forceinline__ float fsigmoid(float v) { return __builtin_amdgcn_rcpf(1.f + __builtin_amdgcn_exp2f(-1.4426950408889634f * v)); }
__device__ __forceinline__ float siluf(float v) { return v * fsigmoid(v); }
__device__ __forceinline__ float shx(float v, int m, int lane) { return __int_as_float(__builtin_amdgcn_ds_bpermute((lane ^ m) << 2, __float_as_int(v))); }
__device__ __forceinline__ unsigned shxu(unsigned v, int m, int lane) { return (unsigned)__builtin_amdgcn_ds_bpermute((lane ^ m) << 2, (int)v); }
__device__ __forceinline__ unsigned shdnu(unsigned v, int d, int lane) { return (unsigned)__builtin_amdgcn_ds_bpermute((lane + d) << 2, (int)v); }
__device__ __forceinline__ int shupi(int v, int d, int lane) { return __builtin_amdgcn_ds_bpermute((lane - d) << 2, v); }
__device__ __forceinline__ unsigned shidxu(unsigned v, int src) { return (unsigned)__builtin_amdgcn_ds_bpermute(src << 2, (int)v); }
__device__ __forceinline__ float wave_sum(float v, int lane) {
#pragma unroll
    for (int o = 1; o < 64; o <<= 1) v += shx(v, o, lane);
    return v;
}
__device__ __forceinline__ float wave_max(float v, int lane) {
#pragma unroll
    for (int o = 1; o < 64; o <<= 1) v = fmaxf(v, shx(v, o, lane));
    return v;
}

__device__ __forceinline__ void transpose_item(const float* __restrict__ W, int ldw, int nvalid, bf16_t* __restrict__ WT, int ldt, int dst_row0, int k0, int n0, LAS float* scr, int lane) {
    const int n = n0 + (lane & 31); const bool ok = n < nvalid;
#pragma unroll 8
    for (int i = 0; i < 32; ++i) { const int kk = 2 * i + (lane >> 5); scr[kk * 33 + (lane & 31)] = ok ? W[(size_t)(k0 + kk) * ldw + n] : 0.f; }
    asm volatile("s_waitcnt lgkmcnt(0)" ::: "memory");
    const int c = lane & 7;
#pragma unroll
    for (int j = 0; j < 4; ++j) { const int nl = (lane >> 3) + 8 * j; const LAS float* s = scr + (8 * c) * 33 + nl;
        u32x4 o; o.x = pk2(s[0 * 33], s[1 * 33]); o.y = pk2(s[2 * 33], s[3 * 33]); o.z = pk2(s[4 * 33], s[5 * 33]); o.w = pk2(s[6 * 33], s[7 * 33]);
        *(u32x4*)(WT + (size_t)(dst_row0 + nl) * ldt + k0 + 8 * c) = o; }
    asm volatile("s_waitcnt lgkmcnt(0)" ::: "memory");
}
__device__ __forceinline__ void convert_experts(const float* __restrict__ wgate, const float* __restrict__ wup, const float* __restrict__ wdown, bf16_t* EGU, bf16_t* EDN, LAS float* scr, int gw, int ngw, int lane) {
    for (int it = gw; it < 3 * 8192; it += ngw) {
        const int which = it >> 13, r = it & 8191, e = r >> 8, q = r & 255;
        if (which < 2) { const int kb = q >> 4, nb = q & 15, n0 = nb * 32; const float* W = (which == 0 ? wgate : wup) + (size_t)e * 1024 * 512;
            transpose_item(W, 512, 512, EGU + (size_t)e * 1024 * 1024, 1024, 256 * (n0 >> 7) + (n0 & 127) + 128 * which, kb * 64, n0, scr, lane); }
        else { const int kb = q >> 5, nb = q & 31; transpose_item(wdown + (size_t)e * 512 * 1024, 1024, 1024, EDN + (size_t)e * 1024 * 512, 512, nb * 32, kb * 64, nb * 32, scr, lane); }
    }
}
struct ProArgs { const float *c, *ada_w, *ada_b, *w_in, *w_out, *glu_w, *wgate, *wup, *wdown; unsigned char* ws; int do_small, pad; };
__device__ __forceinline__ void ph_prologue(const ProArgs& a, LAS unsigned char* lds, const int tid, const int bx, const int G) {
    const int lane = tid & 63, wave = tid >> 6;
    const int gw = bx * NWAVES + wave, ngw = G * NWAVES;
    LAS float* scr = (LAS float*)(lds + wave * 8704);
    bf16_t* Wb = (bf16_t*)(a.ws + OFF_W);
    if (a.do_small) {
        for (int u = bx; u < 256; u += G) {
            LAS float* sc = (LAS float*)(lds + 70 * 1024);
            LAS float* red = sc + 4096;
            __syncthreads();
            for (int i = tid; i < 4096; i += 512) sc[i] = siluf(a.c[i]);
            __syncthreads();
            const int col0 = u * 48, l = col0 / 6144, j0 = col0 % 6144;
            if (tid < 480) {
                const int ks = tid / 48, col = tid % 48;
                const float* w = a.ada_w + (size_t)l * 1024 * 6144 + j0 + col;
                float a0 = 0.f, a1 = 0.f, a2 = 0.f, a3 = 0.f;
#pragma unroll 8
                for (int k = ks; k < 1024; k += 10) { const float wv = w[(size_t)k * 6144]; a0 += sc[k] * wv; a1 += sc[1024 + k] * wv; a2 += sc[2048 + k] * wv; a3 += sc[3072 + k] * wv; }
                red[(ks * 48 + col) * 4 + 0] = a0; red[(ks * 48 + col) * 4 + 1] = a1; red[(ks * 48 + col) * 4 + 2] = a2; red[(ks * 48 + col) * 4 + 3] = a3;
            }
            __syncthreads();
            if (tid < 192) { const int b = tid / 48, col = tid % 48; float s = a.ada_b[l * 6144 + j0 + col];
                for (int ks = 0; ks < 10; ++ks) s += red[(ks * 48 + col) * 4 + b];
                ((float*)(a.ws + OFF_MOD))[(l * 4 + b) * 6144 + j0 + col] = s; }
        }
        __syncthreads();
        constexpr int I_IN = 16 * 88, I_OUT = 16 * 32, I_GLU = 6 * 12, I_ALL = 2 * (I_IN + I_OUT + I_GLU);
        for (int it = gw; it < I_ALL; it += ngw) {
            int r = it; const int l = r / (I_IN + I_OUT + I_GLU); r -= l * (I_IN + I_OUT + I_GLU);
            if (r < I_IN) { const int kb = r / 88, nb = r % 88; transpose_item(a.w_in + (size_t)l * D * DIN, DIN, DIN, (bf16_t*)((unsigned char*)Wb + W_WIN) + (size_t)l * PL * D, D, nb * 32, kb * 64, nb * 32, scr, lane); continue; }
            r -= I_IN;
            if (r < I_OUT) { const int kb = r / 32, nb = r % 32; transpose_item(a.w_out + (size_t)l * D * D, D, D, (bf16_t*)((unsigned char*)Wb + W_WOUT) + (size_t)l * D * D, D, nb * 32, kb * 64, nb * 32, scr, lane); continue; }
            r -= I_OUT;
            { const int kb = r / 12, nb = r % 12; transpose_item(a.glu_w + (size_t)l * 384 * 384, 384, 384, (bf16_t*)((unsigned char*)Wb + W_GLU) + (size_t)l * 384 * 384, 384, nb * 32, kb * 64, nb * 32, scr, lane); }
        }
    }
    convert_experts(a.wgate, a.wup, a.wdown, (bf16_t*)((unsigned char*)Wb + W_EGU), (bf16_t*)((unsigned char*)Wb + W_EDN), scr, gw, ngw, lane);
}

struct EpiRes {
    static constexpr bool PERM = false, AFTER_DRAIN = false;
    const float* xin; float* xout; const float* gt;
    __device__ __forceinline__ void operator()(const pg8::f32x4 (&acc)[2][2][4][2], const pg8::Unit& u, int wr, int wc, int fr, int fq) const {
        const int row0 = u.pm * 256 + wr * 64 + fr, col0 = u.pn * 256 + wc * 32 + 4 * fq;
#pragma unroll
        for (int ai = 0; ai < 2; ++ai)
#pragma unroll
            for (int m = 0; m < 4; ++m) { const int row = row0 + ai * 128 + m * 16; const float* gr = gt + (row >> 13) * 6144; const size_t ro = (size_t)row * D;
#pragma unroll
                for (int bj = 0; bj < 2; ++bj)
#pragma unroll
                    for (int n = 0; n < 2; ++n) { const int col = col0 + bj * 128 + n * 16;
                        const pg8::f32x4 g4 = *(const pg8::f32x4*)(gr + col), xi = *(const pg8::f32x4*)(xin + ro + col);
                        *(pg8::f32x4*)(xout + ro + col) = xi + g4 * acc[ai][bj][m][n]; } }
    }
};
struct EpiProj {
    static constexpr bool PERM = true, AFTER_DRAIN = false;
    bf16_t* O; bf16_t* IKC;
    __device__ __forceinline__ void operator()(const pg8::f32x4 (&acc)[2][2][4][2], const pg8::Unit& u, int wr, int wc, int fr, int fq) const {
        const int row0 = u.pm * 256 + wr * 64 + fr, col0 = u.pn * 256 + wc * 32 + 8 * fq;
#pragma unroll
        for (int ai = 0; ai < 2; ++ai)
#pragma unroll
            for (int m = 0; m < 4; ++m) { const int row = row0 + ai * 128 + m * 16; bf16_t* rowp = O + (size_t)row * PL + col0;
#pragma unroll
                for (int bj = 0; bj < 2; ++bj) { const pg8::f32x4 v0 = acc[ai][bj][m][0], v1 = acc[ai][bj][m][1];
                    u32x4 w; w.x = pg8::cvt_pk_bf16(v0[0], v0[1]); w.y = pg8::cvt_pk_bf16(v0[2], v0[3]); w.z = pg8::cvt_pk_bf16(v1[0], v1[1]); w.w = pg8::cvt_pk_bf16(v1[2], v1[3]);
                    *(u32x4*)(rowp + bj * 128) = w;
                    const int col = col0 + bj * 128;
                    if (col >= IK && col < IK + 32) *(u32x4*)(IKC + (size_t)row * 32 + (col - IK)) = w; } }
    }
};
struct EpiGU {
    static constexpr bool PERM = true, AFTER_DRAIN = false;
    bf16_t* HID;
    __device__ __forceinline__ void operator()(const pg8::f32x4 (&acc)[2][2][4][2], const pg8::Unit& u, int wr, int wc, int fr, int fq) const {
        const int row0 = u.pm * 256 + wr * 64 + fr, col0 = u.pn * 128 + wc * 32 + 8 * fq;
#pragma unroll
        for (int ai = 0; ai < 2; ++ai)
#pragma unroll
            for (int m = 0; m < 4; ++m) { bf16_t* rowp = HID + (size_t)(row0 + ai * 128 + m * 16) * 512 + col0;
                const pg8::f32x4 g0 = acc[ai][0][m][0], g1 = acc[ai][0][m][1], u0 = acc[ai][1][m][0], u1 = acc[ai][1][m][1];
                u32x4 w; w.x = pg8::cvt_pk_bf16(siluf(g0[0]) * u0[0], siluf(g0[1]) * u0[1]); w.y = pg8::cvt_pk_bf16(siluf(g0[2]) * u0[2], siluf(g0[3]) * u0[3]);
                w.z = pg8::cvt_pk_bf16(siluf(g1[0]) * u1[0], siluf(g1[1]) * u1[1]); w.w = pg8::cvt_pk_bf16(siluf(g1[2]) * u1[2], siluf(g1[3]) * u1[3]);
                *(u32x4*)rowp = w; }
    }
};
struct MoeOrder {
    const unsigned* plan; int nN; long estride; int G, c;
    __device__ __forceinline__ void init(int G_, int c_) { G = G_; c = (c_ % 8) * (G_ / 8) + c_ / 8; }
    __device__ __forceinline__ bool next(int i, pg8::Unit& u) const {
        const int ntiles = __builtin_amdgcn_readfirstlane((int)__builtin_nontemporal_load(plan + 72)); const long Lx = (long)i * G + c; if (Lx >= (long)ntiles * nN) return false;
        u.pm = (int)(Lx / nN); u.pn = (int)(Lx % nN); u.boff = (long)__builtin_amdgcn_readfirstlane((int)__builtin_nontemporal_load(plan + 128 + u.pm)) * estride; return true;
    }
    __device__ __forceinline__ void a_ready(const pg8::Unit&) const {}
    __device__ __forceinline__ void done(const pg8::Unit&) const {}
};

typedef short bf16x8_t __attribute__((ext_vector_type(8)));
typedef float f32x16_t __attribute__((ext_vector_type(16)));
typedef short s16x4_t __attribute__((ext_vector_type(4)));
struct Params { const float* in[31]; float* out; unsigned char* ws; };

__device__ __forceinline__ void ph_norm1(const float* xin, const float* __restrict__ g, const float* __restrict__ modl, bf16_t* __restrict__ out, const int tid, const int bx, const int G) {
    const int wave = tid >> 6, lane = tid & 63;
    for (int row = bx * NWAVES + wave; row < T; row += G * NWAVES) {
        const int b = row / L; const float* xr = xin + (size_t)row * D;
        f32x4 v[4]; float ss = 0.f;
#pragma unroll
        for (int i = 0; i < 4; ++i) { v[i] = *(const f32x4*)(xr + 4 * lane + 256 * i); ss += v[i].x * v[i].x + v[i].y * v[i].y + v[i].z * v[i].z + v[i].w * v[i].w; }
        ss = wave_sum(ss, lane);
        const float r = rsqrtf(ss * (1.f / D) + 1e-6f);
#pragma unroll
        for (int i = 0; i < 4; ++i) {
            const int col = 4 * lane + 256 * i;
            const f32x4 gg = *(const f32x4*)(g + col), sc = *(const f32x4*)(modl + b * 6144 + 1024 + col), sh = *(const f32x4*)(modl + b * 6144 + col);
            const f32x4 y = v[i] * r * gg * (sc + 1.f) + sh;
            u32x2 o; o.x = pk2(y.x, y.y); o.y = pk2(y.z, y.w);
            *(u32x2*)(out + (size_t)row * D + col) = o;
        }
    }
}
__device__ __forceinline__ void ph_final_norm(float* X, const float* __restrict__ g, const int tid, const int bx, const int G) {
    const int wave = tid >> 6, lane = tid & 63;
    for (int row = bx * NWAVES + wave; row < T; row += G * NWAVES) {
        float* xr = X + (size_t)row * D;
        f32x4 v[4]; float ss = 0.f;
#pragma unroll
        for (int i = 0; i < 4; ++i) { v[i] = *(const f32x4*)(xr + 4 * lane + 256 * i); ss += v[i].x * v[i].x + v[i].y * v[i].y + v[i].z * v[i].z + v[i].w * v[i].w; }
        ss = wave_sum(ss, lane);
        const float r = rsqrtf(ss * (1.f / D) + 1e-6f);
#pragma unroll
        for (int i = 0; i < 4; ++i) { const int col = 4 * lane + 256 * i; *(f32x4*)(xr + col) = v[i] * r * *(const f32x4*)(g + col); }
    }
}

__device__ __forceinline__ float log_sigmoidf(float x) { return fminf(x, 0.f) - log1pf(expf(-fabsf(x))); }
__device__ __forceinline__ float fexp(float x) { return __builtin_amdgcn_exp2f(x * 1.4426950408889634f); }
__device__ __forceinline__ float log_sigmoid_fast(float x) { return fminf(x, 0.f) - 0.6931471805599453f * __builtin_amdgcn_logf(1.f + fexp(-fabsf(x))); }
__device__ __forceinline__ float pj(const bf16_t* __restrict__ P, int row, int col) { return bf2f(P[(size_t)row * PL + col]); }
constexpr int GLA_QDT = 0, GLA_KDT = GLA_QDT + 48 * 68 * 4, GLA_ATT = GLA_KDT + 48 * 68 * 4, GLA_V = GLA_ATT + 64 * 68 * 4, GLA_KH = GLA_V + 64 * 100 * 4, GLA_S = GLA_KH + 64 * 52 * 4,
              GLA_BC = GLA_S + 48 * 100 * 4, GLA_DEC = GLA_BC + 64 * 49 * 4, GLA_RED = GLA_DEC + 64 * 4, GLA_PART = GLA_RED + 64 * 24 * 4, GLA_GW = GLA_PART + 8 * 48 * 4, GLA_RR = GLA_GW + 17 * 48 * 4, GLA_END = GLA_RR + 64 * 96 * 2;
static_assert(GLA_END <= 160 * 1024, "GLA LDS");
struct GlaRaw { u32x4 l0, l1, q, k; u32x2 v0, v1, v2, r0, r1, r2; };
template <bool FULL>
__device__ __forceinline__ void gla_load_raw(GlaRaw& R, const bf16_t* __restrict__ P, int t0, int h, int tid) {
    const bf16_t* row = P + (size_t)(t0 + (tid >> 3)) * PL; const int jg = tid & 7;
    R.l0 = *(const u32x4*)(row + OLR); R.l1 = *(const u32x4*)(row + OLR + 8);
    R.k.x = *(const unsigned*)(row + OKK + h * 48 + 6 * jg); R.k.y = *(const unsigned*)(row + OKK + h * 48 + 6 * jg + 2); R.k.z = *(const unsigned*)(row + OKK + h * 48 + 6 * jg + 4); R.k.w = 0u;
    R.v0 = *(const u32x2*)(row + OV + h * 96 + 12 * jg); R.v1 = *(const u32x2*)(row + OV + h * 96 + 12 * jg + 4); R.v2 = *(const u32x2*)(row + OV + h * 96 + 12 * jg + 8);
    R.q = (u32x4){0u, 0u, 0u, 0u}; R.r0 = (u32x2){0u, 0u}; R.r1 = R.r0; R.r2 = R.r0;
    if (FULL) { R.q.x = *(const unsigned*)(row + OQ + h * 48 + 6 * jg); R.q.y = *(const unsigned*)(row + OQ + h * 48 + 6 * jg + 2); R.q.z = *(const unsigned*)(row + OQ + h * 48 + 6 * jg + 4);
        R.r0 = *(const u32x2*)(row + ORR + h * 96 + 12 * jg); R.r1 = *(const u32x2*)(row + ORR + h * 96 + 12 * jg + 4); R.r2 = *(const u32x2*)(row + ORR + h * 96 + 12 * jg + 8); }
}
template <bool FULL>
__device__ __forceinline__ void gla_unit(int unit, int tid, LAS unsigned char* sm, const bf16_t* __restrict__ P, const float* __restrict__ gw, const float* __restrict__ gb, const float* __restrict__ ng,
                                         float* __restrict__ GSUM, bf16_t* __restrict__ CAT) {
    typedef LAS float (*a68_t)[68]; typedef LAS float (*a100_t)[100]; typedef LAS float (*a52_t)[52]; typedef LAS float (*a49_t)[49]; typedef LAS float (*a24_t)[24]; typedef LAS float (*a48_t)[48];
    a68_t qdT = (a68_t)(sm + GLA_QDT); a68_t kdT = (a68_t)(sm + GLA_KDT); a68_t attT = (a68_t)(sm + GLA_ATT); a100_t vs = (a100_t)(sm + GLA_V); a52_t kh = (a52_t)(sm + GLA_KH);
    a100_t Ss = (a100_t)(sm + GLA_S); a49_t bc = (a49_t)(sm + GLA_BC); LAS float* dec = (LAS float*)(sm + GLA_DEC); a24_t red = (a24_t)(sm + GLA_RED); LAS float* part = (LAS float*)(sm + GLA_PART);
    a48_t gwl = (a48_t)(sm + GLA_GW);
    LAS bf16_t* rr = (LAS bf16_t*)(sm + GLA_RR);
    const int seg = unit & 15, h = (unit >> 4) & 3, b = unit >> 6;
    GlaRaw cur; gla_load_raw<FULL>(cur, P, b * L + (seg * 8) * 64, h, tid);
    __syncthreads();
    for (int i = tid; i < 17 * 48; i += 512) { const int r = i / 48, j = i % 48; gwl[r][j] = (r < 16) ? gw[r * 192 + h * 48 + j] : gb[h * 48 + j]; }
    float pdec = 1.f;
    if (FULL) {
        float sv[9];
#pragma unroll
        for (int i = 0; i < 9; ++i) sv[i] = 0.f;
        const float* base = GSUM + (size_t)(unit - seg) * 4672;
#pragma unroll 4
        for (int sp = 0; sp < seg; ++sp) {
            const float* su = base + (size_t)sp * 4672;
#pragma unroll
            for (int i = 0; i < 9; ++i) { const int e = tid + 512 * i; sv[i] = su[4608 + e / 96] * sv[i] + su[e]; }
        }
#pragma unroll
        for (int i = 0; i < 9; ++i) { const int e = tid + 512 * i; Ss[e / 96][e % 96] = sv[i]; }
    } else {
        for (int e = tid; e < 4608; e += 512) Ss[e / 96][e % 96] = 0.f;
    }
    for (int c = 0; c < 8; ++c) {
        const int t0 = b * L + (seg * 8 + c) * 64;
        GlaRaw nxt = cur;
        if (c < 7) gla_load_raw<FULL>(nxt, P, t0 + 64, h, tid);
        int tidc = tid; asm volatile("" : "+v"(tidc));
        const int rt = tidc >> 3, jg = tidc & 7;
        __syncthreads();
        {
            const unsigned lw[8] = {cur.l0.x, cur.l0.y, cur.l0.z, cur.l0.w, cur.l1.x, cur.l1.y, cur.l1.z, cur.l1.w};
            float a[6];
#pragma unroll
            for (int i = 0; i < 6; ++i) a[i] = gwl[16][6 * jg + i];
#pragma unroll
            for (int r = 0; r < 8; ++r) { const float x0 = __uint_as_float(lw[r] << 16), x1 = __uint_as_float(lw[r] & 0xffff0000u);
#pragma unroll
                for (int i = 0; i < 6; ++i) a[i] += x0 * gwl[2 * r][6 * jg + i] + x1 * gwl[2 * r + 1][6 * jg + i]; }
#pragma unroll
            for (int i = 0; i < 6; ++i) bc[rt][6 * jg + i] = log_sigmoid_fast(a[i]) * (1.f / 16.f);
        }
        __syncthreads();
        float loc[8]; const int cj = tidc % 48, cp = tidc / 48;
        if (tidc < 384) { float s = 0.f;
#pragma unroll
            for (int r = 0; r < 8; ++r) { s += bc[cp * 8 + r][cj]; loc[r] = s; }
            part[cp * 48 + cj] = s; }
        __syncthreads();
        if (tidc < 384) { float off = 0.f;
#pragma unroll
            for (int q = 0; q < 8; ++q) off += (q < cp) ? part[q * 48 + cj] : 0.f;
#pragma unroll
            for (int r = 0; r < 8; ++r) bc[cp * 8 + r][cj] = loc[r] + off; }
        __syncthreads();
        {
#pragma unroll
            for (int i = 0; i < 6; ++i) {
                const int j = 6 * jg + i; const float bcv = bc[rt][j], bl = bc[63][j];
                const unsigned kw = (i >> 1) == 0 ? cur.k.x : (i >> 1) == 1 ? cur.k.y : cur.k.z; const float kv = (i & 1) ? __uint_as_float(kw & 0xffff0000u) : __uint_as_float(kw << 16);
                kh[rt][j] = kv * fexp(bl - bcv);
                if (FULL) { const unsigned qw = (i >> 1) == 0 ? cur.q.x : (i >> 1) == 1 ? cur.q.y : cur.q.z; const float qv = (i & 1) ? __uint_as_float(qw & 0xffff0000u) : __uint_as_float(qw << 16);
                    kdT[j][rt] = kv * fexp(-bcv); qdT[j][rt] = qv * 0.14433756729740643f * fexp(bcv); }
            }
#pragma unroll
            for (int i = 0; i < 3; ++i) { const u32x2 w = i == 0 ? cur.v0 : i == 1 ? cur.v1 : cur.v2;
                *(LAS f32x4*)&vs[rt][12 * jg + 4 * i] = (f32x4){__uint_as_float(w.x << 16), __uint_as_float(w.x & 0xffff0000u), __uint_as_float(w.y << 16), __uint_as_float(w.y & 0xffff0000u)};
                if (FULL) *(LAS u32x2*)(rr + rt * 96 + 12 * jg + 4 * i) = (i == 0 ? cur.r0 : i == 1 ? cur.r1 : cur.r2); }
            if (tidc < 48) { const float d = fexp(bc[63][tidc]); dec[tidc] = d; pdec *= d; }
        }
        __syncthreads();
        if (FULL) {
            if (tidc < 256) {
                const int tb = tidc >> 4, sb = tidc & 15;
                if (sb <= tb) {
                    float a[4][4];
#pragma unroll
                    for (int i = 0; i < 4; ++i)
#pragma unroll
                        for (int k = 0; k < 4; ++k) a[i][k] = 0.f;
                    for (int j0 = 0; j0 < 48; j0 += 4) {
                        f32x4 q4[4], k4[4];
#pragma unroll
                        for (int u = 0; u < 4; ++u) { q4[u] = *(const LAS f32x4*)&qdT[j0 + u][4 * tb]; k4[u] = *(const LAS f32x4*)&kdT[j0 + u][4 * sb]; }
#pragma unroll
                        for (int u = 0; u < 4; ++u) { const float qq[4] = {q4[u].x, q4[u].y, q4[u].z, q4[u].w}, kk[4] = {k4[u].x, k4[u].y, k4[u].z, k4[u].w};
#pragma unroll
                            for (int i = 0; i < 4; ++i)
#pragma unroll
                                for (int k = 0; k < 4; ++k) a[i][k] += qq[i] * kk[k]; }
                    }
#pragma unroll
                    for (int k = 0; k < 4; ++k) { f32x4 w; w.x = (4 * sb + k <= 4 * tb + 0) ? a[0][k] : 0.f; w.y = (4 * sb + k <= 4 * tb + 1) ? a[1][k] : 0.f; w.z = (4 * sb + k <= 4 * tb + 2) ? a[2][k] : 0.f; w.w = (4 * sb + k <= 4 * tb + 3) ? a[3][k] : 0.f;
                        *(LAS f32x4*)&attT[4 * sb + k][4 * tb] = w; }
                }
            }
            __syncthreads();
            const int tb = tidc / 24, eb = tidc % 24;
            float o[4][4];
#pragma unroll
            for (int i = 0; i < 4; ++i)
#pragma unroll
                for (int k = 0; k < 4; ++k) o[i][k] = 0.f;
            if (tidc < 384) {
                for (int s0 = 0; s0 < 4 * tb + 4; s0 += 4) {
                    f32x4 a4[4], v4[4];
#pragma unroll
                    for (int u = 0; u < 4; ++u) { a4[u] = *(const LAS f32x4*)&attT[s0 + u][4 * tb]; v4[u] = *(const LAS f32x4*)&vs[s0 + u][4 * eb]; }
#pragma unroll
                    for (int u = 0; u < 4; ++u) { const float aa[4] = {a4[u].x, a4[u].y, a4[u].z, a4[u].w}, vv[4] = {v4[u].x, v4[u].y, v4[u].z, v4[u].w};
#pragma unroll
                        for (int i = 0; i < 4; ++i)
#pragma unroll
                            for (int k = 0; k < 4; ++k) o[i][k] += aa[i] * vv[k]; }
                }
                for (int d0 = 0; d0 < 48; d0 += 4) {
                    f32x4 q4[4], s4[4];
#pragma unroll
                    for (int u = 0; u < 4; ++u) { q4[u] = *(const LAS f32x4*)&qdT[d0 + u][4 * tb]; s4[u] = *(const LAS f32x4*)&Ss[d0 + u][4 * eb]; }
#pragma unroll
                    for (int u = 0; u < 4; ++u) { const float qq[4] = {q4[u].x, q4[u].y, q4[u].z, q4[u].w}, ss4[4] = {s4[u].x, s4[u].y, s4[u].z, s4[u].w};
#pragma unroll
                        for (int i = 0; i < 4; ++i)
#pragma unroll
                            for (int k = 0; k < 4; ++k) o[i][k] += qq[i] * ss4[k]; }
                }
#pragma unroll
                for (int i = 0; i < 4; ++i) red[4 * tb + i][eb] = o[i][0] * o[i][0] + o[i][1] * o[i][1] + o[i][2] * o[i][2] + o[i][3] * o[i][3];
            }
            __syncthreads();
            if (tidc < 384) {
                const f32x4 g4 = *(const f32x4*)(ng + 4 * eb);
#pragma unroll
                for (int i = 0; i < 4; ++i) {
                    const int t = 4 * tb + i; float ssum = 0.f;
#pragma unroll
                    for (int q = 0; q < 24; ++q) ssum += red[t][q];
                    const float rn = rsqrtf(ssum * (1.f / 96.f) + 1e-6f);
                    const u32x2 rw = *(const LAS u32x2*)(rr + t * 96 + 4 * eb);
                    const float r0 = __uint_as_float(rw.x << 16), r1 = __uint_as_float(rw.x & 0xffff0000u), r2 = __uint_as_float(rw.y << 16), r3 = __uint_as_float(rw.y & 0xffff0000u);
                    u32x2 w; w.x = pk2(o[i][0] * rn * g4.x * siluf(r0), o[i][1] * rn * g4.y * siluf(r1)); w.y = pk2(o[i][2] * rn * g4.z * siluf(r2), o[i][3] * rn * g4.w * siluf(r3));
                    *(u32x2*)(CAT + (size_t)(t0 + t) * D + h * 96 + 4 * eb) = w;
                }
            }
        }
        if (tidc < 288) {
            const int db = tidc / 24, eb = tidc % 24;
            float u[4][4];
#pragma unroll
            for (int i = 0; i < 4; ++i)
#pragma unroll
                for (int k = 0; k < 4; ++k) u[i][k] = 0.f;
            for (int tq0 = 0; tq0 < 64; tq0 += 4) {
                f32x4 k4[4], v4[4];
#pragma unroll
                for (int u2 = 0; u2 < 4; ++u2) { k4[u2] = *(const LAS f32x4*)&kh[tq0 + u2][4 * db]; v4[u2] = *(const LAS f32x4*)&vs[tq0 + u2][4 * eb]; }
#pragma unroll
                for (int u2 = 0; u2 < 4; ++u2) { const float kk[4] = {k4[u2].x, k4[u2].y, k4[u2].z, k4[u2].w}, vv[4] = {v4[u2].x, v4[u2].y, v4[u2].z, v4[u2].w};
#pragma unroll
                    for (int i = 0; i < 4; ++i)
#pragma unroll
                        for (int k = 0; k < 4; ++k) u[i][k] += kk[i] * vv[k]; }
            }
#pragma unroll
            for (int i = 0; i < 4; ++i) { const float dd = dec[4 * db + i]; f32x4 s4 = *(const LAS f32x4*)&Ss[4 * db + i][4 * eb];
                s4.x = dd * s4.x + u[i][0]; s4.y = dd * s4.y + u[i][1]; s4.z = dd * s4.z + u[i][2]; s4.w = dd * s4.w + u[i][3];
                *(LAS f32x4*)&Ss[4 * db + i][4 * eb] = s4; }
        }
        cur = nxt;
    }
    if (!FULL) {
        __syncthreads();
        float* su = GSUM + (size_t)unit * 4672;
        for (int e = tid; e < 4608; e += 512) su[e] = Ss[e / 96][e % 96];
        if (tid < 48) su[4608 + tid] = pdec;
    }
}

typedef float f32x2_t __attribute__((ext_vector_type(2)));
struct S5Coef { float lr, li; f32x2_t bb[16]; };
__device__ __forceinline__ void s5_coef(const float* __restrict__ a_re, const float* __restrict__ a_im, const float* __restrict__ log_step, const float* __restrict__ b_re, const float* __restrict__ b_im, int g, int p, S5Coef& C) {
    const float dt = expf(log_step[g]);
    const float ar = a_re[g * 64 + p], ai = a_im[g * 64 + p];
    const float mag = expf(ar * dt);
    C.lr = mag * cosf(ai * dt); C.li = mag * sinf(ai * dt);
    const float den = ar * ar + ai * ai, nr = C.lr - 1.f, ni = C.li;
    const float cr = (nr * ar + ni * ai) / den, ci = (ni * ar - nr * ai) / den;
#pragma unroll
    for (int c4 = 0; c4 < 4; ++c4) { const float4 br4 = *(const float4*)(b_re + (g * 64 + p) * 16 + 4 * c4), bi4 = *(const float4*)(b_im + (g * 64 + p) * 16 + 4 * c4);
        const float brv[4] = {br4.x, br4.y, br4.z, br4.w}, biv[4] = {bi4.x, bi4.y, bi4.z, bi4.w};
#pragma unroll
        for (int k = 0; k < 4; ++k) C.bb[4 * c4 + k] = (f32x2_t){cr * brv[k] - ci * biv[k], cr * biv[k] + ci * brv[k]}; }
}
__device__ __forceinline__ float gelu_tanh(float x) { const float u = 0.7978845608028654f * (x + 0.044715f * x * x * x); return x * fsigmoid(2.f * u); }
typedef float f32x4m_t __attribute__((ext_vector_type(4)));
constexpr int S5_YT = 0, S5_YSTR = 784, S5_UT = 128 * S5_YSTR, S5_HT = S5_UT + 8 * 2048, S5_HSTR = 272, S5_SSP = S5_HT + 8 * 16 * S5_HSTR, S5_RSTD = S5_SSP + 8 * 128 * 4, S5_END = S5_RSTD + 128 * 4;
static_assert(S5_END <= 160 * 1024, "S5 LDS");
template <bool P2>
__device__ __forceinline__ void s5_unit(int unit, int tid, LAS unsigned char* sm, const bf16_t* __restrict__ P, const float* __restrict__ a_re, const float* __restrict__ a_im, const float* __restrict__ log_step,
                                        const float* __restrict__ b_re, const float* __restrict__ b_im, const float* __restrict__ c_re, const float* __restrict__ c_im, const float* __restrict__ dd,
                                        float* __restrict__ E, const bf16_t* __restrict__ GLUT, const float* __restrict__ glub, const float* __restrict__ ng, bf16_t* __restrict__ CAT,
                                        const bf16_t* __restrict__ HNA = nullptr, const bf16_t* __restrict__ WB = nullptr, bf16_t* __restrict__ PW = nullptr) {
    const int wave = __builtin_amdgcn_readfirstlane(tid >> 6), lane = tid & 63, b = unit >> 6, seg = unit & 63, t0 = b * L + seg * 128;
    if (!P2) {
        constexpr int BST = 2064;
        __syncthreads();
#pragma unroll
        for (int it = 0; it < 16; ++it) { const int ch = it * 8 + wave, n = ch >> 1, hf = ch & 1;
            __builtin_amdgcn_global_load_lds((const unsigned*)(WB + (size_t)n * 1024 + hf * 512 + lane * 8), (LAS unsigned*)(sm + n * BST + hf * 1024), 16, 0, 0); }
        asm volatile("s_waitcnt vmcnt(0)" ::: "memory");
        __syncthreads();
        const int mr = lane & 15, mq = lane >> 4;
        const bf16_t* ap = HNA + (size_t)(t0 + 16 * wave + mr) * 1024 + 8 * mq;
        f32x4m_t acc0 = {0.f, 0.f, 0.f, 0.f}, acc1 = acc0, acc2 = acc0, acc3 = acc0;
#pragma unroll 1
        for (int kh = 0; kh < 2; ++kh) {
            u32x4 av[16];
#pragma unroll
            for (int i = 0; i < 16; ++i) av[i] = *(const u32x4*)(ap + 32 * (16 * kh + i));
#pragma unroll
            for (int i = 0; i < 16; ++i) {
                const int ks = 16 * kh + i;
                const bf16x8_t a = __builtin_bit_cast(bf16x8_t, av[i]);
                const LAS unsigned char* bp = sm + mr * BST + (32 * ks + 8 * mq) * 2;
                const bf16x8_t b0 = *(const LAS bf16x8_t*)bp, b1 = *(const LAS bf16x8_t*)(bp + 16 * BST), b2 = *(const LAS bf16x8_t*)(bp + 32 * BST), b3 = *(const LAS bf16x8_t*)(bp + 48 * BST);
                acc0 = __builtin_amdgcn_mfma_f32_16x16x32_bf16(b0, a, acc0, 0, 0, 0); acc1 = __builtin_amdgcn_mfma_f32_16x16x32_bf16(b1, a, acc1, 0, 0, 0);
                acc2 = __builtin_amdgcn_mfma_f32_16x16x32_bf16(b2, a, acc2, 0, 0, 0); acc3 = __builtin_amdgcn_mfma_f32_16x16x32_bf16(b3, a, acc3, 0, 0, 0);
            }
        }
        bf16_t* op = PW + (size_t)(t0 + 16 * wave + mr) * PL + 2560 + 4 * mq;
        { u32x2 w; w.x = pk2(acc0[0], acc0[1]); w.y = pk2(acc0[2], acc0[3]); *(u32x2*)(op) = w; }
        { u32x2 w; w.x = pk2(acc1[0], acc1[1]); w.y = pk2(acc1[2], acc1[3]); *(u32x2*)(op + 16) = w; }
        { u32x2 w; w.x = pk2(acc2[0], acc2[1]); w.y = pk2(acc2[2], acc2[3]); *(u32x2*)(op + 32) = w; }
        { u32x2 w; w.x = pk2(acc3[0], acc3[1]); w.y = pk2(acc3[2], acc3[3]); *(u32x2*)(op + 48) = w; }
        __threadfence_block();
    }
    LAS unsigned char* Yt = sm + S5_YT;
    LAS float* ut = (LAS float*)(sm + S5_UT + wave * 2048);
    LAS unsigned char* Ht = sm + S5_HT + wave * 16 * S5_HSTR;
    const int fr = lane & 15, fq = lane >> 4;
    float c0r = 0.f, c0i = 0.f, c1r = 0.f, c1i = 0.f, c2r = 0.f, c2i = 0.f;
    if (P2) {
        float L0r, L0i, L1r, L1i, L2r, L2i;
#define S5_LAM(gi_, Lr_, Li_) do { const int g_ = 3 * wave + (gi_); const float dt_ = expf(log_step[g_]); const float ar_ = a_re[g_ * 64 + lane], ai_ = a_im[g_ * 64 + lane]; const float mag_ = expf(ar_ * dt_); \
            Lr_ = mag_ * cosf(ai_ * dt_); Li_ = mag_ * sinf(ai_ * dt_); \
            _Pragma("unroll") for (int i = 0; i < 7; ++i) { const float nr_ = Lr_ * Lr_ - Li_ * Li_, ni_ = 2.f * Lr_ * Li_; Lr_ = nr_; Li_ = ni_; } } while (0)
        S5_LAM(0, L0r, L0i); S5_LAM(1, L1r, L1i); S5_LAM(2, L2r, L2i);
#undef S5_LAM
        const float* ep = E + ((size_t)(unit - seg) * 24 + 3 * wave) * 128 + 2 * lane;
#pragma unroll 8
        for (int sp = 0; sp < seg; ++sp) {
            const float2 e0 = *(const float2*)(ep + (size_t)sp * 24 * 128), e1 = *(const float2*)(ep + (size_t)sp * 24 * 128 + 128), e2 = *(const float2*)(ep + (size_t)sp * 24 * 128 + 256);
            { const float nr = L0r * c0r - L0i * c0i + e0.x, ni = L0r * c0i + L0i * c0r + e0.y; c0r = nr; c0i = ni; }
            { const float nr = L1r * c1r - L1i * c1i + e1.x, ni = L1r * c1i + L1i * c1r + e1.y; c1r = nr; c1i = ni; }
            { const float nr = L2r * c2r - L2i * c2i + e2.x, ni = L2r * c2i + L2i * c2r + e2.y; c2r = nr; c2i = ni; }
        }
    }
    __syncthreads();
    for (int gi = 0; gi < 3; ++gi) {
        const int g = 3 * wave + gi;
        S5Coef C; s5_coef(a_re, a_im, log_step, b_re, b_im, g, lane, C);
        float hr = gi == 0 ? c0r : gi == 1 ? c1r : c2r, hi = gi == 0 ? c0i : gi == 1 ? c1i : c2i;
        bf16x8_t cfr[4]; float dco = 0.f;
        if (P2) {
#pragma unroll
            for (int ks = 0; ks < 4; ++ks) {
                const size_t co = (size_t)(g * 16 + fr) * 64 + 16 * ks + 4 * fq;
                const float4 vr = *(const float4*)(c_re + co), vi = *(const float4*)(c_im + co);
                u32x4 w; w.x = pk2(vr.x, -vi.x); w.y = pk2(vr.y, -vi.y); w.z = pk2(vr.z, -vi.z); w.w = pk2(vr.w, -vi.w);
                cfr[ks] = __builtin_bit_cast(bf16x8_t, w);
            }
            dco = dd[g * 16 + fr];
        }
        u32x4 unext = *(const u32x4*)(P + (size_t)(t0 + (lane >> 1)) * PL + SU + 16 * g + 8 * (lane & 1));
        for (int tb = 0; tb < 4; ++tb) {
            { const u32x4 w = unext;
              if (tb < 3) unext = *(const u32x4*)(P + (size_t)(t0 + (tb + 1) * 32 + (lane >> 1)) * PL + SU + 16 * g + 8 * (lane & 1));
              LAS f32x4* dst = (LAS f32x4*)(ut + (lane >> 1) * 16 + 8 * (lane & 1));
              dst[0] = (f32x4){__uint_as_float(w.x << 16), __uint_as_float(w.x & 0xffff0000u), __uint_as_float(w.y << 16), __uint_as_float(w.y & 0xffff0000u)};
              dst[1] = (f32x4){__uint_as_float(w.z << 16), __uint_as_float(w.z & 0xffff0000u), __uint_as_float(w.w << 16), __uint_as_float(w.w & 0xffff0000u)}; }
            asm volatile("s_waitcnt lgkmcnt(0)" ::: "memory");
#pragma unroll 1
            for (int hb = 0; hb < 2; ++hb) {
                const LAS f32x4* upb = (const LAS f32x4*)(ut + (hb * 16) * 16);
                f32x4 nu0 = upb[0], nu1 = upb[1], nu2 = upb[2], nu3 = upb[3];
#pragma unroll
                for (int tt = 0; tt < 16; ++tt) {
                    const f32x4 u0 = nu0, u1 = nu1, u2 = nu2, u3 = nu3;
                    if (tt < 15) { nu0 = upb[4 * (tt + 1)]; nu1 = upb[4 * (tt + 1) + 1]; nu2 = upb[4 * (tt + 1) + 2]; nu3 = upb[4 * (tt + 1) + 3]; }
                    const float uu[16] = {u0.x, u0.y, u0.z, u0.w, u1.x, u1.y, u1.z, u1.w, u2.x, u2.y, u2.z, u2.w, u3.x, u3.y, u3.z, u3.w};
                    f32x2_t xa = {0.f, 0.f}, xb = {0.f, 0.f};
#pragma unroll
                    for (int c = 0; c < 16; c += 2) { xa += (f32x2_t){uu[c], uu[c]} * C.bb[c]; xb += (f32x2_t){uu[c + 1], uu[c + 1]} * C.bb[c + 1]; }
                    const f32x2_t hv = {hr, hi}, hs = {hi, hr};
                    const f32x2_t hn = (xa + xb) + (f32x2_t){C.lr, C.lr} * hv + (f32x2_t){-C.li, C.li} * hs;
                    hr = hn.x; hi = hn.y;
                    if (P2) *(LAS unsigned*)(Ht + tt * S5_HSTR + lane * 4) = pk2(hr, hi);
                }
                if (P2) {
                    asm volatile("s_waitcnt lgkmcnt(0)" ::: "memory");
                    f32x4m_t acc = {0.f, 0.f, 0.f, 0.f};
#pragma unroll
                    for (int ks = 0; ks < 4; ++ks) { const bf16x8_t a = *(const LAS bf16x8_t*)(Ht + fr * S5_HSTR + (32 * ks + 8 * fq) * 2); acc = __builtin_amdgcn_mfma_f32_16x16x32_bf16(a, cfr[ks], acc, 0, 0, 0); }
#pragma unroll
                    for (int r = 0; r < 4; ++r) { const int tl = hb * 16 + 4 * fq + r; const float y = acc[r] + dco * ut[tl * 16 + fr];
                        *(LAS bf16_t*)(Yt + (tb * 32 + tl) * S5_YSTR + (16 * g + fr) * 2) = (bf16_t)f2bf(gelu_tanh(y)); }
                    asm volatile("s_waitcnt lgkmcnt(0)" ::: "memory");
                }
            }
        }
        if (!P2) { float* eo = E + ((size_t)unit * 24 + g) * 128 + 2 * lane; eo[0] = hr; eo[1] = hi; }
    }
    if (P2) {
        __syncthreads();
        const int j0 = 48 * wave;
        f32x4m_t acc[8][3];
#pragma unroll
        for (int rt = 0; rt < 8; ++rt)
#pragma unroll
            for (int ct = 0; ct < 3; ++ct) acc[rt][ct] = (f32x4m_t){0.f, 0.f, 0.f, 0.f};
        u32x4 bwn0 = *(const u32x4*)(GLUT + (size_t)(j0 + fr) * 384 + 8 * fq), bwn1 = *(const u32x4*)(GLUT + (size_t)(j0 + 16 + fr) * 384 + 8 * fq), bwn2 = *(const u32x4*)(GLUT + (size_t)(j0 + 32 + fr) * 384 + 8 * fq);
#pragma unroll 1
        for (int ks = 0; ks < 12; ++ks) {
            bf16x8_t bw[3];
            bw[0] = __builtin_bit_cast(bf16x8_t, bwn0); bw[1] = __builtin_bit_cast(bf16x8_t, bwn1); bw[2] = __builtin_bit_cast(bf16x8_t, bwn2);
            if (ks < 11) { const bf16_t* gp = GLUT + (size_t)(j0 + fr) * 384 + 32 * (ks + 1) + 8 * fq; bwn0 = *(const u32x4*)gp; bwn1 = *(const u32x4*)(gp + 16 * 384); bwn2 = *(const u32x4*)(gp + 32 * 384); }
#pragma unroll
            for (int rt = 0; rt < 8; ++rt) { const bf16x8_t a = *(const LAS bf16x8_t*)(Yt + (16 * rt + fr) * S5_YSTR + (32 * ks + 8 * fq) * 2);
#pragma unroll
                for (int ct = 0; ct < 3; ++ct) acc[rt][ct] = __builtin_amdgcn_mfma_f32_16x16x32_bf16(a, bw[ct], acc[rt][ct], 0, 0, 0); }
        }
        LAS float* ssp = (LAS float*)(sm + S5_SSP); LAS float* rstd = (LAS float*)(sm + S5_RSTD);
        float gb3[3], gn3[3];
#pragma unroll
        for (int ct = 0; ct < 3; ++ct) { gb3[ct] = glub[j0 + 16 * ct + fr]; gn3[ct] = ng[j0 + 16 * ct + fr]; }
#pragma unroll
        for (int rt = 0; rt < 8; ++rt)
#pragma unroll
            for (int r = 0; r < 4; ++r) { const int t = 16 * rt + 4 * fq + r; float s = 0.f;
#pragma unroll
                for (int ct = 0; ct < 3; ++ct) { const float yv = bf2f(*(const LAS bf16_t*)(Yt + t * S5_YSTR + (j0 + 16 * ct + fr) * 2)); const float z = yv * fsigmoid(acc[rt][ct][r] + gb3[ct]); acc[rt][ct][r] = z; s += z * z; }
                s += shx(s, 1, lane); s += shx(s, 2, lane); s += shx(s, 4, lane); s += shx(s, 8, lane);
                if (fr == 0) ssp[wave * 128 + t] = s; }
        __syncthreads();
        if (tid < 128) { float s = 0.f;
#pragma unroll
            for (int w8 = 0; w8 < 8; ++w8) s += ssp[w8 * 128 + tid];
            rstd[tid] = rsqrtf(s * (1.f / 384.f) + 1e-6f); }
        __syncthreads();
#pragma unroll
        for (int rt = 0; rt < 8; ++rt)
#pragma unroll
            for (int r = 0; r < 4; ++r) { const int t = 16 * rt + 4 * fq + r; const float rn = rstd[t];
#pragma unroll
                for (int ct = 0; ct < 3; ++ct) *(LAS bf16_t*)(Yt + t * S5_YSTR + (j0 + 16 * ct + fr) * 2) = (bf16_t)f2bf(acc[rt][ct][r] * rn * gn3[ct]); }
        __syncthreads();
        for (int i = tid; i < 128 * 48; i += 512) { const int t = i / 48, ch = i % 48; *(u32x4*)(CAT + (size_t)(t0 + t) * D + 640 + 8 * ch) = *(const LAS u32x4*)(Yt + t * S5_YSTR + 16 * ch); }
    }
}

__device__ __forceinline__ float relu1(float x) { return __builtin_amdgcn_fmed3f(x, 0.f, __builtin_inff()); }
__device__ __forceinline__ unsigned qbin_of_key(unsigned u) {
    const unsigned bits = (u & 0x80000000u) ? (u & 0x7fffffffu) : ~u;
    const float f = __uint_as_float(bits);
    return (unsigned)(int)fminf(fmaxf((f + 4.0f) * 64.0f, 0.f), 1023.f);
}
struct TkPre { u32x4 af0, af1; f32x4 w0, w1, w2, w3; u32x4 b00, b01, b02, b03, b10, b11, b12, b13; };
__device__ __forceinline__ void topk_prefetch(TkPre& R, int vb, const bf16_t* __restrict__ P, const bf16_t* __restrict__ IKC, const int tid) {
    const int wv = tid >> 6, lane = tid & 63, hl = lane >> 5, row = lane & 31, qi_a = row >> 3, hh_a = row & 7;
    const int t0 = vb * 4, b = t0 / L, tl0 = t0 % L, ntiles = (tl0 + 3) / 32 + 1;
    const bf16_t* ap = P + (size_t)(t0 + qi_a) * PL + IQ + hh_a * 32 + 8 * hl;
    R.af0 = *(const u32x4*)ap; R.af1 = *(const u32x4*)(ap + 16);
    const float4 x0 = ld4bf(P + (size_t)(t0 + 0) * PL + IW + 4 * hl), x1 = ld4bf(P + (size_t)(t0 + 1) * PL + IW + 4 * hl), x2 = ld4bf(P + (size_t)(t0 + 2) * PL + IW + 4 * hl), x3 = ld4bf(P + (size_t)(t0 + 3) * PL + IW + 4 * hl);
    R.w0 = (f32x4){x0.x, x0.y, x0.z, x0.w} * 0.0625f; R.w1 = (f32x4){x1.x, x1.y, x1.z, x1.w} * 0.0625f; R.w2 = (f32x4){x2.x, x2.y, x2.z, x2.w} * 0.0625f; R.w3 = (f32x4){x3.x, x3.y, x3.z, x3.w} * 0.0625f;
    const bf16_t* ikb = IKC + (size_t)b * L * 32 + 8 * hl;
#define TKP_(u_, d0_, d1_) { int tile_ = wv + 8 * (u_); tile_ = tile_ < ntiles ? tile_ : ntiles - 1; const bf16_t* kp_ = ikb + (size_t)(tile_ * 32 + row) * 32; d0_ = *(const u32x4*)kp_; d1_ = *(const u32x4*)(kp_ + 16); }
    TKP_(0, R.b00, R.b10) TKP_(1, R.b01, R.b11) TKP_(2, R.b02, R.b12) TKP_(3, R.b03, R.b13)
#undef TKP_
}
__device__ __forceinline__ void vb_dsa_topk(int vb, int vb_next, TkPre& PR, LAS unsigned char* sm, const bf16_t* __restrict__ P, const bf16_t* __restrict__ IKC, unsigned long long* __restrict__ MASK, const int tid) {
    constexpr int CAP = 256;
    LAS unsigned* keys = (LAS unsigned*)sm;
    LAS unsigned* hist = (LAS unsigned*)(sm + 131072);
    LAS unsigned* lmask = hist + 4096;
    LAS unsigned* clist = lmask + 1024;
    LAS unsigned* bsel = clist + 4 * CAP * 2;
    const int wv = tid >> 6, w = wv >> 1, hf = wv & 1, lane = tid & 63;
    const int t = vb * 4 + w, b = t / L, tl = t % L, n = tl + 1;
    __syncthreads();
    for (int i = tid; i < 4096; i += 512) hist[i] = 0u;
    for (int i = tid; i < 1024; i += 512) lmask[i] = 0u;
    if (tid < 32) bsel[tid] = 0u;
    __syncthreads();
    {
        const int t0 = vb * 4, hl = lane >> 5, row = lane & 31, tl0 = t0 % L;
        bf16x8_t af[2]; af[0] = __builtin_bit_cast(bf16x8_t, PR.af0); af[1] = __builtin_bit_cast(bf16x8_t, PR.af1);
        const f32x4 wv4[4] = {PR.w0, PR.w1, PR.w2, PR.w3};
        const int ntiles = (tl0 + 3) / 32 + 1;
        const bf16_t* ikb = IKC + (size_t)b * L * 32 + 8 * hl;
        u32x4 nb0[4] = {PR.b00, PR.b01, PR.b02, PR.b03}, nb1[4] = {PR.b10, PR.b11, PR.b12, PR.b13};
#define TOPK_LOAD(tg_) do { _Pragma("unroll") for (int u = 0; u < 4; ++u) { int tile_ = (tg_) + 8 * u; tile_ = tile_ < ntiles ? tile_ : ntiles - 1; const bf16_t* kp_ = ikb + (size_t)(tile_ * 32 + row) * 32; nb0[u] = *(const u32x4*)kp_; nb1[u] = *(const u32x4*)(kp_ + 16); } } while (0)
        for (int tg = wv; tg < ntiles; tg += 32) {
            u32x4 cb0[4], cb1[4];
#pragma unroll
            for (int u = 0; u < 4; ++u) { cb0[u] = nb0[u]; cb1[u] = nb1[u]; }
            if (tg + 32 < ntiles) TOPK_LOAD(tg + 32);
#pragma unroll
            for (int u = 0; u < 4; ++u) {
                const int tile = tg + 8 * u, key = tile * 32 + row;
                f32x16_t c;
#pragma unroll
                for (int r = 0; r < 16; ++r) c[r] = 0.f;
                c = __builtin_amdgcn_mfma_f32_32x32x16_bf16(af[0], __builtin_bit_cast(bf16x8_t, cb0[u]), c, 0, 0, 0);
                c = __builtin_amdgcn_mfma_f32_32x32x16_bf16(af[1], __builtin_bit_cast(bf16x8_t, cb1[u]), c, 0, 0, 0);
                float sc4[4];
#pragma unroll
                for (int qi = 0; qi < 4; ++qi) {
                    float part = wv4[qi].x * relu1(c[qi * 4 + 0]) + wv4[qi].y * relu1(c[qi * 4 + 1]) + wv4[qi].z * relu1(c[qi * 4 + 2]) + wv4[qi].w * relu1(c[qi * 4 + 3]);
                    part += shx(part, 32, lane);
                    sc4[qi] = part;
                }
                const float sa = hl ? sc4[2] : sc4[0], sb = hl ? sc4[3] : sc4[1];
                unsigned ua = __float_as_uint(sa + 0.0f), ub = __float_as_uint(sb + 0.0f);
                ua = (ua & 0x80000000u) ? ~ua : (ua | 0x80000000u); ub = (ub & 0x80000000u) ? ~ub : (ub | 0x80000000u);
                if (tile < ntiles) {
                    keys[(2 * hl) * 8192 + key] = ua; keys[(2 * hl + 1) * 8192 + key] = ub;
                    if (key <= tl0 + 2 * hl) __hip_atomic_fetch_add(&hist[(2 * hl) * 1024 + qbin_of_key(ua)], 1u, __ATOMIC_RELAXED, __HIP_MEMORY_SCOPE_WORKGROUP);
                    if (key <= tl0 + 2 * hl + 1) __hip_atomic_fetch_add(&hist[(2 * hl + 1) * 1024 + qbin_of_key(ub)], 1u, __ATOMIC_RELAXED, __HIP_MEMORY_SCOPE_WORKGROUP);
                }
            }
        }
#undef TOPK_LOAD
    }
    if (vb_next >= 0) topk_prefetch(PR, vb_next, P, IKC, tid);
    LAS unsigned* kw = keys + w * 8192;
    __syncthreads();
    const bool need_sel = n > 256;
    if (need_sel && hf == 0) {
        const LAS u32x4* h1 = (const LAS u32x4*)(hist + w * 1024 + 16 * lane);
        unsigned cs[16]; unsigned tot = 0u;
#pragma unroll
        for (int i = 0; i < 4; ++i) { const u32x4 v4 = h1[i]; cs[4 * i] = v4.x; cs[4 * i + 1] = v4.y; cs[4 * i + 2] = v4.z; cs[4 * i + 3] = v4.w; tot += v4.x + v4.y + v4.z + v4.w; }
        unsigned incl = tot;
#pragma unroll
        for (int o = 1; o < 64; o <<= 1) { const unsigned v = shdnu(incl, o, lane); if (lane + o < 64) incl += v; }
        unsigned cum = incl - tot;
#pragma unroll
        for (int i = 15; i >= 0; --i) {
            if (cum < 256u && cum + cs[i] >= 256u) { bsel[w * 4 + 0] = 16u * lane + i; bsel[w * 4 + 1] = 256u - cum; bsel[w * 4 + 2] = cs[i]; if (cs[i] > (unsigned)CAP && cs[i] != 256u - cum) bsel[20] = 1u; }
            cum += cs[i];
        }
    }
    __syncthreads();
    unsigned bstar = 0u, krem = 256u, ties = 0u, prefix = 0u;
    if (need_sel) { bstar = bsel[w * 4 + 0]; krem = bsel[w * 4 + 1]; ties = bsel[w * 4 + 2]; }
    const bool refine = need_sel && (ties != krem);
    const bool use_list = refine && ties <= (unsigned)CAP;
    const bool any_fallback = bsel[20] != 0u;
    __syncthreads();
    unsigned long long cbits = 0ull;
    for (int j = hf, jl = 0; j < 32; j += 2, ++jl) {
        if (j * 256 >= n) break;
        unsigned long long bal[4];
#pragma unroll
        for (int c = 0; c < 4; ++c) {
            const int s = j * 256 + c * 64 + lane;
            const unsigned u = kw[s]; const unsigned qb = qbin_of_key(u);
            const bool in = s < n;
            const bool sure = in && (!need_sel || qb > bstar || (!refine && qb == bstar));
            bal[c] = __ballot(sure);
            if (use_list && in && qb == bstar) cbits |= 1ull << (4 * jl + c);
        }
        if (lane < 4) { const unsigned long long v = lane == 0 ? bal[0] : lane == 1 ? bal[1] : lane == 2 ? bal[2] : bal[3];
            lmask[w * 256 + (j * 4 + lane) * 2] = (unsigned)v; lmask[w * 256 + (j * 4 + lane) * 2 + 1] = (unsigned)(v >> 32); }
    }
    if (use_list) {
        const unsigned mine = (unsigned)__popcll(cbits);
        unsigned incl = mine;
#pragma unroll
        for (int o = 1; o < 64; o <<= 1) { const unsigned v = (unsigned)shupi((int)incl, o, lane); if (lane >= o) incl += v; }
        unsigned base = 0u;
        if (lane == 63) base = __hip_atomic_fetch_add(&bsel[16 + w], incl, __ATOMIC_RELAXED, __HIP_MEMORY_SCOPE_WORKGROUP);
        base = shidxu(base, 63) + incl - mine;
        while (cbits) {
            const int bit = __ffsll((long long)cbits) - 1; cbits &= cbits - 1ull;
            const int s = (hf + 2 * (bit >> 2)) * 256 + (bit & 3) * 64 + lane;
            *(LAS u32x2*)(clist + (w * CAP + base) * 2) = (u32x2){kw[s], (unsigned)s}; ++base;
        }
    }
    __syncthreads();
    if (use_list) {
        const unsigned mcnt = ties;
        for (unsigned i = lane + 64 * hf; i < mcnt; i += 128) {
            const u32x2 me = *(const LAS u32x2*)(clist + (w * CAP + i) * 2);
            unsigned rank = 0u;
#pragma unroll 8
            for (unsigned jj = 0; jj < mcnt; ++jj) { const u32x2 o2 = *(const LAS u32x2*)(clist + (w * CAP + jj) * 2); rank += (o2.x > me.x || (o2.x == me.x && o2.y < me.y)) ? 1u : 0u; }
            if (rank < krem) __hip_atomic_fetch_or(&lmask[w * 256 + (me.y >> 5)], 1u << (me.y & 31u), __ATOMIC_RELAXED, __HIP_MEMORY_SCOPE_WORKGROUP);
        }
    }
    __syncthreads();
    if (any_fallback) {
        const bool rf = refine && !use_list;
        LAS unsigned* hw = hist + w * 1024;
        for (int pass = 3; pass >= 0; --pass) {
            for (int i = lane + 64 * hf; i < 256; i += 128) hw[i] = 0u;
            __syncthreads();
            if (rf) {
                const int sh = pass * 8;
                for (int s = lane + 64 * hf; s < n; s += 128) {
                    const unsigned u = kw[s];
                    const bool match = (qbin_of_key(u) == bstar) && ((pass == 3) || ((u >> (sh + 8)) == prefix));
                    if (match) __hip_atomic_fetch_add(&hw[(u >> sh) & 255u], 1u, __ATOMIC_RELAXED, __HIP_MEMORY_SCOPE_WORKGROUP);
                }
            }
            __syncthreads();
            if (rf && hf == 0) {
                const unsigned c0 = hw[4 * lane], c1 = hw[4 * lane + 1], c2 = hw[4 * lane + 2], c3 = hw[4 * lane + 3];
                const unsigned tot = c0 + c1 + c2 + c3;
                unsigned incl = tot;
#pragma unroll
                for (int o = 1; o < 64; o <<= 1) { const unsigned v = shdnu(incl, o, lane); if (lane + o < 64) incl += v; }
                unsigned cum = incl - tot;
                const unsigned cs[4] = {c0, c1, c2, c3};
#pragma unroll
                for (int i = 3; i >= 0; --i) {
                    if (cum < krem && cum + cs[i] >= krem) { bsel[w * 4 + 0] = 4u * lane + i; bsel[w * 4 + 1] = krem - cum; bsel[w * 4 + 2] = cs[i]; }
                    cum += cs[i];
                }
            }
            __syncthreads();
            if (rf) { prefix = (prefix << 8) | bsel[w * 4 + 0]; krem = bsel[w * 4 + 1]; ties = bsel[w * 4 + 2]; }
            __syncthreads();
        }
        if (rf && hf == 0) {
            unsigned running = 0u;
            for (int j = 0; j < 128; ++j) {
                const int s = j * 64 + lane;
                const unsigned u = (s < n) ? kw[s] : 0u; const unsigned qb = qbin_of_key(u);
                const bool gt = (s < n) && qb == bstar && u > prefix, eq = (s < n) && qb == bstar && u == prefix;
                const unsigned long long em = __ballot(eq);
                const unsigned rank = running + (unsigned)__popcll(em & ((1ull << lane) - 1ull));
                const bool sel = gt || (eq && rank < krem);
                running += (unsigned)__popcll(em);
                const unsigned long long mm = __ballot(sel);
                if (lane == 0 && mm) { __hip_atomic_fetch_or(&lmask[w * 256 + j * 2], (unsigned)mm, __ATOMIC_RELAXED, __HIP_MEMORY_SCOPE_WORKGROUP); __hip_atomic_fetch_or(&lmask[w * 256 + j * 2 + 1], (unsigned)(mm >> 32), __ATOMIC_RELAXED, __HIP_MEMORY_SCOPE_WORKGROUP); }
            }
        }
        __syncthreads();
    }
    { const int j = lane + 64 * hf; u32x2 v; v.x = lmask[w * 256 + 2 * j]; v.y = lmask[w * 256 + 2 * j + 1]; *(u32x2*)(MASK + (size_t)t * 128 + j) = v; }
}
constexpr int TK4_CAP = 1024, TK4_TARGET = 56, TK4_LIST = 0, TK4_MASK = 65536, TK4_H2 = TK4_MASK + 8192, TK4_PAR = TK4_H2 + 32768, TK4_CL = TK4_PAR + 1024, TK4_END = TK4_CL + 8 * 64 * 8;
static_assert(TK4_END <= 160 * 1024, "topk v4 LDS");
__device__ __forceinline__ unsigned tk4_key(float f) { const unsigned u = __float_as_uint(f + 0.0f); return u ^ ((unsigned)((int)u >> 31) | 0x80000000u); }
struct Tk4Ops { u32x4 a00, a01, a10, a11, a20, a21; f32x4 w0, w1, w2, w3, w4, w5, w6, w7; };
#define TK4_FMA8(acc_, c_, o_, wa_, wb_) do { \
    acc_ = __builtin_fmaf(wa_.x, __builtin_fabsf(c_[o_ + 0]), acc_); acc_ = __builtin_fmaf(wa_.y, __builtin_fabsf(c_[o_ + 1]), acc_); acc_ = __builtin_fmaf(wa_.z, __builtin_fabsf(c_[o_ + 2]), acc_); acc_ = __builtin_fmaf(wa_.w, __builtin_fabsf(c_[o_ + 3]), acc_); \
    acc_ = __builtin_fmaf(wb_.x, __builtin_fabsf(c_[o_ + 4]), acc_); acc_ = __builtin_fmaf(wb_.y, __builtin_fabsf(c_[o_ + 5]), acc_); acc_ = __builtin_fmaf(wb_.z, __builtin_fabsf(c_[o_ + 6]), acc_); acc_ = __builtin_fmaf(wb_.w, __builtin_fabsf(c_[o_ + 7]), acc_); } while (0)
#define TK4_SCORES(b0_, b1_, F_) do { \
    f32x16_t c0_, c1_, c2_; \
    _Pragma("unroll") for (int r_ = 0; r_ < 16; ++r_) { c0_[r_] = 0.f; c1_[r_] = 0.f; c2_[r_] = 0.f; } \
    c0_ = __builtin_amdgcn_mfma_f32_32x32x16_bf16(__builtin_bit_cast(bf16x8_t, A.a00), __builtin_bit_cast(bf16x8_t, b0_), c0_, 0, 0, 0); \
    c1_ = __builtin_amdgcn_mfma_f32_32x32x16_bf16(__builtin_bit_cast(bf16x8_t, A.a10), __builtin_bit_cast(bf16x8_t, b0_), c1_, 0, 0, 0); \
    c2_ = __builtin_amdgcn_mfma_f32_32x32x16_bf16(__builtin_bit_cast(bf16x8_t, A.a20), __builtin_bit_cast(bf16x8_t, b0_), c2_, 0, 0, 0); \
    c0_ = __builtin_amdgcn_mfma_f32_32x32x16_bf16(__builtin_bit_cast(bf16x8_t, A.a01), __builtin_bit_cast(bf16x8_t, b1_), c0_, 0, 0, 0); \
    c1_ = __builtin_amdgcn_mfma_f32_32x32x16_bf16(__builtin_bit_cast(bf16x8_t, A.a11), __builtin_bit_cast(bf16x8_t, b1_), c1_, 0, 0, 0); \
    c2_ = __builtin_amdgcn_mfma_f32_32x32x16_bf16(__builtin_bit_cast(bf16x8_t, A.a21), __builtin_bit_cast(bf16x8_t, b1_), c2_, 0, 0, 0); \
    float f0_ = c2_[0] + c2_[4], f1_ = c2_[1] + c2_[5], f2_ = c2_[2] + c2_[6], f3_ = c2_[3] + c2_[7]; \
    TK4_FMA8(f0_, c0_, 0, A.w0, A.w1); TK4_FMA8(f1_, c0_, 8, A.w2, A.w3); TK4_FMA8(f2_, c1_, 0, A.w4, A.w5); TK4_FMA8(f3_, c1_, 8, A.w6, A.w7); \
    F_[0] = f0_; F_[1] = f1_; F_[2] = f2_; F_[3] = f3_; \
} while (0)
constexpr int TK5_VAL = 0, TK5_IDX = 32768, TK5_OVF = 65536, TK5_MASK = TK5_OVF + 8192, TK5_H2 = TK5_MASK + 8192, TK5_PAR = TK5_H2 + 32768, TK5_CL = TK5_PAR + 1024, TK5_END = TK5_CL + 8 * 64 * 8;
static_assert(TK5_END <= 160 * 1024, "topk v5 LDS");
constexpr int TK5_PRE = 120832;
__device__ __forceinline__ void tk5_prefetch(int un, LAS unsigned char* sm, const bf16_t* __restrict__ P, int tid) {
    const int wave = __builtin_amdgcn_readfirstlane(tid >> 6), lane = tid & 63;
    if (wave < 4) __builtin_amdgcn_global_load_lds((const unsigned*)(P + (size_t)(un * 8 + 2 * wave + (lane >> 5)) * PL + IQ + (lane & 31) * 8), (LAS unsigned*)(sm + TK5_PRE + wave * 1024), 16, 0, 0);
    else if (wave == 4 && lane < 8) __builtin_amdgcn_global_load_lds((const unsigned*)(P + (size_t)(un * 8 + lane) * PL + IW), (LAS unsigned*)(sm + TK5_PRE + 4096), 16, 0, 0);
}
__device__ __forceinline__ void topk5_unit(int u, int un, LAS unsigned char* sm, const bf16_t* __restrict__ P, const bf16_t* __restrict__ IKC, unsigned long long* __restrict__ MASK, const int tid) {
    LAS unsigned* val = (LAS unsigned*)(sm + TK5_VAL);
    LAS unsigned* hist = val;
    LAS u32x2* ovf = (LAS u32x2*)(sm + TK5_OVF);
    LAS unsigned* lmask = (LAS unsigned*)(sm + TK5_MASK);
    LAS unsigned* h2 = (LAS unsigned*)(sm + TK5_H2);
    LAS float* tau = (LAS float*)(sm + TK5_PAR);
    LAS unsigned* cnt = (LAS unsigned*)(sm + TK5_PAR) + 8;
    LAS unsigned* todo = cnt + 8;
    LAS unsigned* wcnt = todo + 16;
    LAS unsigned* ovc = wcnt + 64;
    const int wv = __builtin_amdgcn_readfirstlane(tid >> 6), lane = tid & 63, hl = lane >> 5, row = lane & 31;
    const int t0 = u * 8, b = t0 / L, tl0 = t0 % L;
    const int ntiles = (tl0 + 7) / 32 + 1;
    unsigned zz_ = 0u; asm volatile("" : "+v"(zz_));
    const u32x4 zero4 = (u32x4){zz_, zz_, zz_, zz_};
    __syncthreads();
    for (int i = tid; i < (32768) / 16; i += 512) ((LAS u32x4*)sm)[i] = zero4;
    for (int i = tid; i < (8192 + 32768) / 16; i += 512) ((LAS u32x4*)(sm + TK5_MASK))[i] = zero4;
    if (tid < 128) ((LAS unsigned*)(sm + TK5_PAR))[tid] = 0u;
    LAS bf16_t* ql = (LAS bf16_t*)(sm + TK5_CL);
    if (tid < 256) { const int Q = tid >> 5, d = tid & 31; const LAS unsigned short* qs = (const LAS unsigned short*)(sm + TK5_PRE) + Q * 256 + d;
        const u32x4 wr = *(const LAS u32x4*)(sm + TK5_PRE + 4096 + Q * 16);
#define TK5_BF(x_) __uint_as_float((unsigned)(x_) << 16)
        float acc = __uint_as_float(wr.x << 16) * TK5_BF(qs[0]) + __uint_as_float(wr.x & 0xffff0000u) * TK5_BF(qs[32]) + __uint_as_float(wr.y << 16) * TK5_BF(qs[64]) + __uint_as_float(wr.y & 0xffff0000u) * TK5_BF(qs[96])
                  + __uint_as_float(wr.z << 16) * TK5_BF(qs[128]) + __uint_as_float(wr.z & 0xffff0000u) * TK5_BF(qs[160]) + __uint_as_float(wr.w << 16) * TK5_BF(qs[192]) + __uint_as_float(wr.w & 0xffff0000u) * TK5_BF(qs[224]);
#undef TK5_BF
        acc *= 0.03125f;
        const unsigned short hi = f2bf(acc); const unsigned short lo = f2bf(acc - __uint_as_float((unsigned)hi << 16));
        ql[(Q * 2 + 0) * 32 + d] = (bf16_t)hi; ql[(Q * 2 + 1) * 32 + d] = (bf16_t)lo; }
    Tk4Ops A;
    { const int qig = 2 * ((row >> 2) & 1) + (row >> 4), hh_a = 4 * ((row >> 3) & 1) + (row & 3);
      const bf16_t* ap0 = P + (size_t)(t0 + qig) * PL + IQ + hh_a * 32 + 8 * hl; const bf16_t* ap1 = ap0 + (size_t)4 * PL;
      A.a00 = *(const u32x4*)ap0; A.a01 = *(const u32x4*)(ap0 + 16); A.a10 = *(const u32x4*)ap1; A.a11 = *(const u32x4*)(ap1 + 16);
#define TK4_W(q_, o_) ({ const float4 x_ = ld4bf(P + (size_t)(t0 + (q_)) * PL + IW + (o_)); (f32x4){x_.x, x_.y, x_.z, x_.w} * 0.03125f; })
      A.w0 = TK4_W(2 * hl, 0); A.w1 = TK4_W(2 * hl, 4); A.w2 = TK4_W(2 * hl + 1, 0); A.w3 = TK4_W(2 * hl + 1, 4);
      A.w4 = TK4_W(4 + 2 * hl, 0); A.w5 = TK4_W(4 + 2 * hl, 4); A.w6 = TK4_W(4 + 2 * hl + 1, 0); A.w7 = TK4_W(4 + 2 * hl + 1, 4);
#undef TK4_W
    }
    const bf16_t* ikb = IKC + (size_t)b * L * 32 + 8 * hl;
    __syncthreads();
    {
      const int part = (row >> 3) & 1, Q = 4 * ((row >> 1) & 1) + 2 * ((row >> 2) & 1) + (row & 1);
      const LAS u32x4* qs = (const LAS u32x4*)(ql + (Q * 2 + part) * 32 + 8 * hl);
      A.a20 = row < 16 ? qs[0] : zero4; A.a21 = row < 16 ? qs[2] : zero4; }
    const bool sampled = (tl0 + 7) >= 1024;
    if (sampled) {
        u32x4 sb0[4], sb1[4];
#pragma unroll
        for (int jj = 0; jj < 4; ++jj) { int j = wv + 8 * jj; j = 8 * j < ntiles ? j : 0; const bf16_t* kp = ikb + (size_t)(8 * j * 32 + row) * 32; sb0[jj] = *(const u32x4*)kp; sb1[jj] = *(const u32x4*)(kp + 16); }
#pragma unroll
        for (int jj = 0; jj < 4; ++jj) {
            const int j = wv + 8 * jj;
            if (8 * j < ntiles) {
                const int tile = 8 * j, key = tile * 32 + row;
                float f[4]; TK4_SCORES(sb0[jj], sb1[jj], f);
#pragma unroll
                for (int i = 0; i < 4; ++i) { const int q = 4 * (i >> 1) + 2 * hl + (i & 1);
                    if (key <= tl0 + q) { const unsigned bin = (unsigned)(int)fminf(fmaxf((f[i] + 4.0f) * 64.0f, 0.f), 1023.f); __hip_atomic_fetch_add(&hist[q * 1024 + bin], 1u, __ATOMIC_RELAXED, __HIP_MEMORY_SCOPE_WORKGROUP); } }
            }
        }
    }
    __syncthreads();
    const unsigned char* ikbase = (const unsigned char*)(IKC + (size_t)b * L * 32);
    const unsigned ikoff = (unsigned)(row * 64 + hl * 16);
    u32x4 n1a[2], n1b[2], n2a[2], n2b[2];
#define TK4_LOADQ(A_, B_, tg_) do { _Pragma("unroll") for (int uu = 0; uu < 2; ++uu) { int tile_ = (tg_) + 8 * uu; tile_ = tile_ < ntiles ? tile_ : ntiles - 1; \
        const unsigned char* kp_ = ikbase + (ikoff + (unsigned)tile_ * 2048u); A_[uu] = *(const u32x4*)kp_; B_[uu] = *(const u32x4*)(kp_ + 32); } } while (0)
    TK4_LOADQ(n1a, n1b, wv); TK4_LOADQ(n2a, n2b, wv + 16);
    {
        const int q = wv; const int nq = tl0 + q + 1;
        float tq = -3.0e38f;
        if (nq > 1024) {
            tq = -4.0f;
            const LAS u32x4* h1 = (const LAS u32x4*)(hist + q * 1024 + 16 * lane);
            unsigned cs[16]; unsigned tot = 0u;
#pragma unroll
            for (int i = 0; i < 4; ++i) { const u32x4 v4 = h1[i]; cs[4 * i] = v4.x; cs[4 * i + 1] = v4.y; cs[4 * i + 2] = v4.z; cs[4 * i + 3] = v4.w; tot += v4.x + v4.y + v4.z + v4.w; }
            unsigned incl = tot;
#pragma unroll
            for (int o = 1; o < 64; o <<= 1) { const unsigned v = shdnu(incl, o, lane); if (lane + o < 64) incl += v; }
            unsigned cum = incl - tot; int found = -1;
#pragma unroll
            for (int i = 15; i >= 0; --i) { if (cum < (unsigned)TK4_TARGET && cum + cs[i] >= (unsigned)TK4_TARGET) found = 16 * lane + i; cum += cs[i]; }
            const unsigned long long fm = __ballot(found >= 0);
            if (fm) { const int src = __ffsll((long long)fm) - 1; const int fb = (int)shidxu((unsigned)found, src); tq = (float)fb * (1.f / 64.f) - 4.0f; }
        }
        if (lane == 0) { tau[q] = tq; todo[q] = 1u; }
    }
    __syncthreads();
    { const unsigned nb_ = 0xff800000u + zz_; const u32x4 ninf4 = (u32x4){nb_, nb_, nb_, nb_};
      for (int i = tid; i < 32768 / 16; i += 512) ((LAS u32x4*)(sm + TK5_VAL))[i] = ninf4; }
#pragma unroll 1
    for (int attempt = 0; attempt < 8; ++attempt) {
        __syncthreads();
        if (attempt > 0) {
            TK4_LOADQ(n1a, n1b, wv); TK4_LOADQ(n2a, n2b, wv + 16);
            const unsigned nb_ = 0xff800000u + zz_; const u32x4 ninf4 = (u32x4){nb_, nb_, nb_, nb_};
#pragma unroll 1
            for (int q = 0; q < 8; ++q) if (todo[q] != 0u && tid < 256) ((LAS u32x4*)(sm + TK5_VAL + q * 4096))[tid] = ninf4;
            __syncthreads();
        }
        float tq[4];
        { int hl_a = hl; asm volatile("" : "+v"(hl_a));
#pragma unroll
          for (int i = 0; i < 4; ++i) { const int q = 4 * (i >> 1) + 2 * hl_a + (i & 1); tq[i] = todo[q] != 0u ? tau[q] : __builtin_inff(); } }
        unsigned cl0 = 0u, cl1 = 0u, cl2 = 0u, cl3 = 0u;
        LAS unsigned* vbase = val + ((2 * hl * 8 + wv) * 128 + row * 4);
#define TK5_FILT1(F_, i_, CN_, key2_, key_) do { \
            if ((key2_) <= tl0 + 4 * ((i_) >> 1) + ((i_) & 1) && F_[i_] >= tq[i_]) { \
                if (CN_ < 4u) { LAS unsigned* le_ = vbase + ((4 * ((i_) >> 1) + ((i_) & 1)) * 1024) + CN_; le_[0] = __float_as_uint(F_[i_]); le_[8192] = (unsigned)(key_); } \
                else { int hl_r = hl; asm volatile("" : "+v"(hl_r));        \
                       const int q_ = 4 * ((i_) >> 1) + 2 * hl_r + ((i_) & 1); const unsigned p_ = __hip_atomic_fetch_add(&ovc[q_], 1u, __ATOMIC_RELAXED, __HIP_MEMORY_SCOPE_WORKGROUP); \
                       if (p_ < 128u) ovf[q_ * 128 + p_] = (u32x2){__float_as_uint(F_[i_]), (unsigned)(key_)}; } \
                CN_ += 1u; } } while (0)
#define TK5_FILTER(F_, TILE_) do { const int key_ = (TILE_) * 32 + row, key2_ = key_ - 2 * hl; TK5_FILT1(F_, 0, cl0, key2_, key_); TK5_FILT1(F_, 1, cl1, key2_, key_); TK5_FILT1(F_, 2, cl2, key2_, key_); TK5_FILT1(F_, 3, cl3, key2_, key_); } while (0)
#define TK5_ITER(A_, B_, TG_) do { const int tg_ = (TG_); float fA_[4], fB_[4]; TK4_SCORES(A_[0], B_[0], fA_); __builtin_amdgcn_sched_barrier(0); TK4_SCORES(A_[1], B_[1], fB_); \
            if (tg_ + 32 < ntiles) TK4_LOADQ(A_, B_, tg_ + 32); \
            TK5_FILTER(fA_, tg_); TK5_FILTER(fB_, tg_ + 8); } while (0)
#pragma unroll 1
        for (int tg = wv; tg < ntiles; tg += 32) {
            TK5_ITER(n1a, n1b, tg);
            if (tg + 16 >= ntiles) break;
            TK5_ITER(n2a, n2b, tg + 16);
        }
#undef TK5_ITER
#undef TK5_FILTER
#undef TK5_FILT1
        int lane_p = lane; asm volatile("" : "+v"(lane_p));
#pragma unroll
        for (int o = 1; o < 32; o <<= 1) { cl0 += shxu(cl0, o, lane_p); cl1 += shxu(cl1, o, lane_p); cl2 += shxu(cl2, o, lane_p); cl3 += shxu(cl3, o, lane_p); }
        if ((lane_p & 31) == 0) {
            const int qb = 2 * (lane_p >> 5);
            if (todo[qb]) wcnt[qb * 8 + wv] = cl0; if (todo[qb + 1]) wcnt[(qb + 1) * 8 + wv] = cl1; if (todo[qb + 4]) wcnt[(qb + 4) * 8 + wv] = cl2; if (todo[qb + 5]) wcnt[(qb + 5) * 8 + wv] = cl3;
        }
        __syncthreads();
        int tid_c = tid; asm volatile("" : "+v"(tid_c));
        if (tid_c < 8) {
            const int q = tid_c; const unsigned nq = (unsigned)(tl0 + q + 1), need = nq < 256u ? nq : 256u;
            unsigned td = 0u;
            if (todo[q]) { unsigned mq = 0u;
#pragma unroll
                for (int w8 = 0; w8 < 8; ++w8) mq += wcnt[q * 8 + w8];
                cnt[q] = mq;
                if (mq < need) { tau[q] = (attempt >= 2) ? -4.0f : tau[q] - 0.25f * (float)(attempt + 1); td = 1u; }
                else if (ovc[q] > 128u) { tau[q] = tau[q] + (1.f / 64.f) * (float)(1u + (mq > 700u ? (mq - 700u) / 48u : 0u)); td = 1u; }
                if (td) ovc[q] = 0u;
            }
            todo[q] = td; if (td) todo[8] = 1u;
        }
        __syncthreads();
        const bool again = todo[8] != 0u;
        __syncthreads();
        if (tid == 0) todo[8] = 0u;
        if (!again) break;
    }
    __syncthreads();
#undef TK4_LOADQ
    if (un >= 0) tk5_prefetch(un, sm, P, tid);
    {
        int lane_o = lane; asm volatile("" : "+v"(lane_o)); const int lane = lane_o;
        const int q = wv; const unsigned nq = (unsigned)(tl0 + q + 1);
        const unsigned mq = cnt[q]; unsigned ovn = ovc[q]; ovn = ovn < 128u ? ovn : 128u;
        LAS unsigned* hq = h2 + q * 1024; LAS unsigned* mk = lmask + q * 256;
        const float NINF = -__builtin_inff();
        float v[18]; unsigned ix[18];
        { const LAS unsigned* vq = val + q * 1024 + lane;
#pragma unroll
          for (int k = 0; k < 16; ++k) { v[k] = __uint_as_float(vq[64 * k]); ix[k] = vq[64 * k + 8192]; }
#pragma unroll
          for (int k = 0; k < 2; ++k) { v[16 + k] = NINF; ix[16 + k] = 0u; if ((unsigned)(lane + 64 * k) < ovn) { const u32x2 e = ovf[q * 128 + lane + 64 * k]; v[16 + k] = __uint_as_float(e.x); ix[16 + k] = e.y; } } }
        if (mq <= 256u || nq <= 256u) {
#pragma unroll
            for (int k = 0; k < 18; ++k) if (v[k] > NINF) __hip_atomic_fetch_or(&mk[ix[k] >> 5], 1u << (ix[k] & 31u), __ATOMIC_RELAXED, __HIP_MEMORY_SCOPE_WORKGROUP);
        } else {
            float fmn = 3.0e38f, fmx = -3.0e38f;
#pragma unroll
            for (int k = 0; k < 18; ++k) { fmn = v[k] > NINF ? fminf(fmn, v[k]) : fmn; fmx = fmaxf(fmx, v[k]); }
#pragma unroll
            for (int o = 1; o < 64; o <<= 1) { const float a_ = shx(fmn, o, lane), b_ = shx(fmx, o, lane); fmn = fminf(fmn, a_); fmx = fmaxf(fmx, b_); }
            float lo0 = fmn, sc0 = 1023.0f / fmaxf(fmx - fmn, 1e-30f), lo1 = 0.f, sc1 = 0.f, lo2 = 0.f, sc2 = 0.f, lo3 = 0.f, sc3 = 0.f;
            unsigned bs0 = 0u, bs1 = 0u, bs2 = 0u, need = 256u;
#define TK4_B(f_, lo_, sc_) ((unsigned)(int)fminf(fmaxf(((f_) - (lo_)) * (sc_), 0.f), 1023.f))
#define TK5_ACT(f_) ((f_) > NINF && (lv < 1 || TK4_B(f_, lo0, sc0) == bs0) && (lv < 2 || TK4_B(f_, lo1, sc1) == bs1) && (lv < 3 || TK4_B(f_, lo2, sc2) == bs2))
            bool sel_done = false;
            { constexpr int lv = 0;
                const float lo = lv == 0 ? lo0 : lv == 1 ? lo1 : lv == 2 ? lo2 : lo3, sc = lv == 0 ? sc0 : lv == 1 ? sc1 : lv == 2 ? sc2 : sc3;
#pragma unroll
                for (int j = 0; j < 4; ++j) ((LAS u32x4*)hq)[4 * lane + j] = zero4;
                asm volatile("s_waitcnt lgkmcnt(0)" ::: "memory");
#pragma unroll
                for (int k = 0; k < 18; ++k) if (TK5_ACT(v[k])) __hip_atomic_fetch_add(&hq[TK4_B(v[k], lo, sc)], 1u, __ATOMIC_RELAXED, __HIP_MEMORY_SCOPE_WORKGROUP);
                asm volatile("s_waitcnt lgkmcnt(0)" ::: "memory");
                unsigned bstar = 0u, nd = 0u, pop = 0u;
                { const LAS u32x4* h1 = (const LAS u32x4*)(hq + 16 * lane);
                  unsigned cs[16]; unsigned tot = 0u;
#pragma unroll
                  for (int i = 0; i < 4; ++i) { const u32x4 v4 = h1[i]; cs[4 * i] = v4.x; cs[4 * i + 1] = v4.y; cs[4 * i + 2] = v4.z; cs[4 * i + 3] = v4.w; tot += v4.x + v4.y + v4.z + v4.w; }
                  unsigned incl = tot;
#pragma unroll
                  for (int o = 1; o < 64; o <<= 1) { const unsigned s_ = shdnu(incl, o, lane); if (lane + o < 64) incl += s_; }
                  unsigned cum = incl - tot; int fd = -1; unsigned fk = 0u, ft = 0u;
#pragma unroll
                  for (int i = 15; i >= 0; --i) { if (cum < need && cum + cs[i] >= need) { fd = 16 * lane + i; fk = need - cum; ft = cs[i]; } cum += cs[i]; }
                  const unsigned long long fm = __ballot(fd >= 0); const int src = __ffsll((long long)fm) - 1;
                  bstar = shidxu((unsigned)fd, src); nd = shidxu(fk, src); pop = shidxu(ft, src); }
                const bool fin = pop <= 64u || lv == 3;
                LAS u32x2* cl = (LAS u32x2*)(sm + TK5_CL) + q * 64; unsigned ccnt = 0u;
                {
                    unsigned cmask = 0u, mycnt = 0u;
#pragma unroll
                    for (int k = 0; k < 18; ++k) {
                        const bool act = v[k] > NINF; const unsigned bn = TK4_B(v[k], lo, sc);
                        if (act && bn > bstar) __hip_atomic_fetch_or(&mk[ix[k] >> 5], 1u << (ix[k] & 31u), __ATOMIC_RELAXED, __HIP_MEMORY_SCOPE_WORKGROUP);
                        const bool cd = fin && act && bn == bstar; cmask |= cd ? (1u << k) : 0u; mycnt += cd ? 1u : 0u;
                    }
                    unsigned incl = mycnt;
#pragma unroll
                    for (int o = 1; o < 64; o <<= 1) { const unsigned s_ = (unsigned)shupi((int)incl, o, lane); if (lane >= o) incl += s_; }
                    ccnt = shidxu(incl, 63);
                    unsigned off = incl - mycnt;
                    if (cmask) {
#pragma unroll
                        for (int k = 0; k < 18; ++k) if (cmask & (1u << k)) { if (off < 64u) cl[off] = (u32x2){__float_as_uint(v[k]), ix[k]}; ++off; }
                    }
                }
                if (fin) {
                    asm volatile("s_waitcnt lgkmcnt(0)" ::: "memory");
                    ccnt = ccnt < 64u ? ccnt : 64u;
                    if (lane < (int)ccnt) { const u32x2 me = cl[lane]; unsigned rk = 0u;
                        for (unsigned jj = 0; jj < ccnt; ++jj) { const u32x2 o2 = cl[jj]; const float of = __uint_as_float(o2.x), mf = __uint_as_float(me.x); rk += (of > mf || (of == mf && o2.y < me.y)) ? 1u : 0u; }
                        if (rk < nd) __hip_atomic_fetch_or(&mk[me.y >> 5], 1u << (me.y & 31u), __ATOMIC_RELAXED, __HIP_MEMORY_SCOPE_WORKGROUP); }
                    sel_done = true;
                }
                if (!sel_done) {
                const float nlo = lo + (float)bstar / sc, nsc = sc * 1024.0f;
                if (lv == 0) { bs0 = bstar; lo1 = nlo; sc1 = nsc; } else if (lv == 1) { bs1 = bstar; lo2 = nlo; sc2 = nsc; } else { bs2 = bstar; lo3 = nlo; sc3 = nsc; }
                need = nd;
                            }
            }
#pragma unroll 1
            for (int lv = 1; lv < 4 && !sel_done; ++lv) {
                const float lo = lv == 0 ? lo0 : lv == 1 ? lo1 : lv == 2 ? lo2 : lo3, sc = lv == 0 ? sc0 : lv == 1 ? sc1 : lv == 2 ? sc2 : sc3;
#pragma unroll
                for (int j = 0; j < 4; ++j) ((LAS u32x4*)hq)[4 * lane + j] = zero4;
                asm volatile("s_waitcnt lgkmcnt(0)" ::: "memory");
#pragma unroll
                for (int k = 0; k < 18; ++k) if (TK5_ACT(v[k])) __hip_atomic_fetch_add(&hq[TK4_B(v[k], lo, sc)], 1u, __ATOMIC_RELAXED, __HIP_MEMORY_SCOPE_WORKGROUP);
                asm volatile("s_waitcnt lgkmcnt(0)" ::: "memory");
                unsigned bstar = 0u, nd = 0u, pop = 0u;
                { const LAS u32x4* h1 = (const LAS u32x4*)(hq + 16 * lane);
                  unsigned cs[16]; unsigned tot = 0u;
#pragma unroll
                  for (int i = 0; i < 4; ++i) { const u32x4 v4 = h1[i]; cs[4 * i] = v4.x; cs[4 * i + 1] = v4.y; cs[4 * i + 2] = v4.z; cs[4 * i + 3] = v4.w; tot += v4.x + v4.y + v4.z + v4.w; }
                  unsigned incl = tot;
#pragma unroll
                  for (int o = 1; o < 64; o <<= 1) { const unsigned s_ = shdnu(incl, o, lane); if (lane + o < 64) incl += s_; }
                  unsigned cum = incl - tot; int fd = -1; unsigned fk = 0u, ft = 0u;
#pragma unroll
                  for (int i = 15; i >= 0; --i) { if (cum < need && cum + cs[i] >= need) { fd = 16 * lane + i; fk = need - cum; ft = cs[i]; } cum += cs[i]; }
                  const unsigned long long fm = __ballot(fd >= 0); const int src = __ffsll((long long)fm) - 1;
                  bstar = shidxu((unsigned)fd, src); nd = shidxu(fk, src); pop = shidxu(ft, src); }
                const bool fin = pop <= 64u || lv == 3;
                LAS u32x2* cl = (LAS u32x2*)(sm + TK5_CL) + q * 64; unsigned ccnt = 0u;
#pragma unroll
                for (int k = 0; k < 18; ++k) {
                    const bool act = TK5_ACT(v[k]); const unsigned bn = TK4_B(v[k], lo, sc);
                    if (act && bn > bstar) __hip_atomic_fetch_or(&mk[ix[k] >> 5], 1u << (ix[k] & 31u), __ATOMIC_RELAXED, __HIP_MEMORY_SCOPE_WORKGROUP);
                    const bool cd = fin && act && bn == bstar; const unsigned long long cm = __ballot(cd);
                    const unsigned cp = ccnt + (unsigned)__popcll(cm & ((1ull << lane) - 1ull));
                    if (cd && cp < 64u) cl[cp] = (u32x2){__float_as_uint(v[k]), ix[k]};
                    ccnt += (unsigned)__popcll(cm);
                }
                if (fin) {
                    asm volatile("s_waitcnt lgkmcnt(0)" ::: "memory");
                    ccnt = ccnt < 64u ? ccnt : 64u;
                    if (lane < (int)ccnt) { const u32x2 me = cl[lane]; unsigned rk = 0u;
                        for (unsigned jj = 0; jj < ccnt; ++jj) { const u32x2 o2 = cl[jj]; const float of = __uint_as_float(o2.x), mf = __uint_as_float(me.x); rk += (of > mf || (of == mf && o2.y < me.y)) ? 1u : 0u; }
                        if (rk < nd) __hip_atomic_fetch_or(&mk[me.y >> 5], 1u << (me.y & 31u), __ATOMIC_RELAXED, __HIP_MEMORY_SCOPE_WORKGROUP); }
                    break;
                }
                const float nlo = lo + (float)bstar / sc, nsc = sc * 1024.0f;
                if (lv == 0) { bs0 = bstar; lo1 = nlo; sc1 = nsc; } else if (lv == 1) { bs1 = bstar; lo2 = nlo; sc2 = nsc; } else { bs2 = bstar; lo3 = nlo; sc3 = nsc; }
                need = nd;
                        }
#undef TK5_ACT
#undef TK4_B
        }
    }
    __syncthreads();
    for (int i = tid; i < 8 * 128; i += 512) { const int q = i >> 7, j = i & 127; u32x2 v; v.x = lmask[q * 256 + 2 * j]; v.y = lmask[q * 256 + 2 * j + 1]; *(u32x2*)(MASK + (size_t)(t0 + q) * 128 + j) = v; }
}

__device__ __forceinline__ s16x4_t lds_tr16(const LAS unsigned char* p) { return __builtin_bit_cast(s16x4_t, __builtin_amdgcn_ds_read_tr16_b64_v4i16((LAS s16x4_t*)p)); }
__device__ __forceinline__ void dsa_issue_tile(const unsigned char* tile, unsigned koff, unsigned voff, LAS unsigned char* buf, int wave) {
#pragma unroll
    for (int i = 0; i < 4; ++i)
        __builtin_amdgcn_global_load_lds((const unsigned*)(tile + (koff + (unsigned)i * (16u * PL * 2u))), (LAS unsigned*)(buf + (512 * i + wave * 64) * 16), 16, 0, 0);
#pragma unroll
    for (int i = 0; i < 4; ++i)
        __builtin_amdgcn_global_load_lds((const unsigned*)(tile + (voff + (unsigned)i * 128u)), (LAS unsigned*)(buf + 32768 + (512 * i + wave * 64) * 16), 16, 0, 0);
}
__device__ __forceinline__ void dsa_attn_unit(int b, int qb, LAS unsigned char* lds, const bf16_t* __restrict__ PROJ, const unsigned long long* __restrict__ MASK, const float* __restrict__ ng, bf16_t* __restrict__ CAT, int tid) {
    const int wave = __builtin_amdgcn_readfirstlane(tid >> 6), lane = tid & 63, h = wave & 3, rb = wave >> 2, q = lane & 31, hl = lane >> 5;
    const size_t trow = (size_t)b * L + qb * 64 + rb * 32 + q;
    const float C2 = 0.125f * 1.4426950408889634f, NEG = -1e30f; const unsigned NEGB = __float_as_uint(NEG);
    bf16x8_t qf[4];
#pragma unroll
    for (int ds = 0; ds < 4; ++ds) {
        const u32x4 w = *(const u32x4*)(PROJ + trow * PL + DQ + h * 64 + 16 * ds + 8 * hl);
        u32x4 o;
        o.x = pk2(__uint_as_float(w.x << 16) * C2, __uint_as_float(w.x & 0xffff0000u) * C2); o.y = pk2(__uint_as_float(w.y << 16) * C2, __uint_as_float(w.y & 0xffff0000u) * C2);
        o.z = pk2(__uint_as_float(w.z << 16) * C2, __uint_as_float(w.z & 0xffff0000u) * C2); o.w = pk2(__uint_as_float(w.w << 16) * C2, __uint_as_float(w.w & 0xffff0000u) * C2);
        qf[ds] = __builtin_bit_cast(bf16x8_t, o);
    }
    f32x16_t o0, o1;
#pragma unroll
    for (int r = 0; r < 16; ++r) { o0[r] = 0.f; o1[r] = 0.f; }
    float m_ref = 0.f; f32x2_t lsum = (f32x2_t){0.f, 0.f}; bool shifted = false;
    const unsigned char* mbase = (const unsigned char*)((const unsigned*)MASK + (size_t)b * L * 256);
    const unsigned moff = (unsigned)(((qb * 64 + rb * 32 + (lane >> 1)) * 256 + (lane & 1)) * 4);
    LAS unsigned char* mbuf = lds + 132096 + wave * 512;
    const unsigned char* kv0 = (const unsigned char*)(PROJ + (size_t)b * L * PL);
    const unsigned koff = (unsigned)(((tid >> 5) * PL + DK + ((tid & 31) >> 3) * 64 + (((tid & 7) ^ ((tid >> 5) & 7)) * 8)) * 2);
    const unsigned voff = (unsigned)((((tid >> 2) & 63) * PL + DV + (tid >> 8) * 32 + (tid & 3) * 8) * 2);
    __syncthreads();
    __builtin_amdgcn_global_load_lds((const unsigned*)(mbase + moff), (LAS unsigned*)mbuf, 4, 0, 0);
    dsa_issue_tile(kv0, koff, voff, lds, wave);
    asm volatile("s_waitcnt vmcnt(0)" ::: "memory");
    __syncthreads();
    const int kro = q * 512 + h * 128;
    const int i16 = lane & 15, c0 = 16 * ((lane >> 4) & 1);
    const int vro = (h * 2) * 4096 + (4 * hl + (i16 >> 2)) * 64 + (c0 + 4 * (i16 & 3)) * 2;
    for (int j = 0; j <= qb; ++j) {
        LAS unsigned char* Kb = lds + (j & 1) * 65536; LAS unsigned char* Vb = Kb + 32768;
        if (j < qb) {
            unsigned ko_ = koff, vo_ = voff, mo_ = moff; asm volatile("" : "+v"(ko_), "+v"(vo_), "+v"(mo_));
            __builtin_amdgcn_global_load_lds((const unsigned*)(mbase + (mo_ + (unsigned)(j + 1) * 8u)), (LAS unsigned*)(mbuf + ((j + 1) & 1) * 256), 4, 0, 0);
            dsa_issue_tile(kv0 + (size_t)(j + 1) * 64 * PL * 2, ko_, vo_, lds + ((j + 1) & 1) * 65536, wave);
        }
        f32x16_t p0, p1;
#pragma unroll
        for (int r = 0; r < 16; ++r) { p0[r] = 0.f; p1[r] = 0.f; }
#pragma unroll
        for (int ds = 0; ds < 4; ++ds) {
            const int co = ((2 * ds + hl) ^ (q & 7)) * 16;
            const bf16x8_t a0 = *(const LAS bf16x8_t*)(Kb + kro + co), a1 = *(const LAS bf16x8_t*)(Kb + kro + 32 * 512 + co);
            p0 = __builtin_amdgcn_mfma_f32_32x32x16_bf16(a0, qf[ds], p0, 0, 0, 0);
            p1 = __builtin_amdgcn_mfma_f32_32x32x16_bf16(a1, qf[ds], p1, 0, 0, 0);
        }
        const u32x2 mw = *(const LAS u32x2*)(mbuf + (j & 1) * 256 + q * 8);
        const unsigned mlo = mw.x >> (4 * hl), mhi = mw.y >> (4 * hl);
        if (shifted) {
#pragma unroll
            for (int r = 0; r < 16; ++r) { p0[r] -= m_ref; p1[r] -= m_ref; }
        }
        float mx = NEG;
#pragma unroll
        for (int r = 0; r < 16; ++r) {
            const int kk = (r & 3) + 8 * (r >> 2);
            const unsigned s0 = (unsigned)__builtin_amdgcn_sbfe((int)mlo, kk, 1), s1 = (unsigned)__builtin_amdgcn_sbfe((int)mhi, kk, 1);
            p0[r] = __uint_as_float((__float_as_uint(p0[r]) & s0) | (NEGB & ~s0)); p1[r] = __uint_as_float((__float_as_uint(p1[r]) & s1) | (NEGB & ~s1));
            asm("v_max3_f32 %0, %1, %2, %3" : "=v"(mx) : "v"(mx), "v"(p0[r]), "v"(p1[r]));
        }
        { const float mo = shx(mx, 32, lane); asm("v_max_f32 %0, %1, %2" : "=v"(mx) : "v"(mx), "v"(mo)); }
        const bool move = mx > -1e29f && __builtin_fabsf(mx) > 40.f;
        if (__ballot(move)) {
            const float dlt = move ? mx : 0.f, alpha = __builtin_amdgcn_exp2f(-dlt);
            m_ref += dlt; lsum *= alpha; shifted = true;
#pragma unroll
            for (int r = 0; r < 16; ++r) { o0[r] *= alpha; o1[r] *= alpha; p0[r] -= dlt; p1[r] -= dlt; }
        }
#pragma unroll
        for (int r = 0; r < 16; r += 2) {
            p0[r] = __builtin_amdgcn_exp2f(p0[r]); p0[r + 1] = __builtin_amdgcn_exp2f(p0[r + 1]); p1[r] = __builtin_amdgcn_exp2f(p1[r]); p1[r + 1] = __builtin_amdgcn_exp2f(p1[r + 1]);
            lsum += (f32x2_t){p0[r], p0[r + 1]}; lsum += (f32x2_t){p1[r], p1[r + 1]};
        }
        bf16x8_t pf[4];
#pragma unroll
        for (int s = 0; s < 2; ++s) {
            u32x4 a, c;
            a.x = pk2(p0[8 * s + 0], p0[8 * s + 1]); a.y = pk2(p0[8 * s + 2], p0[8 * s + 3]); a.z = pk2(p0[8 * s + 4], p0[8 * s + 5]); a.w = pk2(p0[8 * s + 6], p0[8 * s + 7]);
            c.x = pk2(p1[8 * s + 0], p1[8 * s + 1]); c.y = pk2(p1[8 * s + 2], p1[8 * s + 3]); c.z = pk2(p1[8 * s + 4], p1[8 * s + 5]); c.w = pk2(p1[8 * s + 6], p1[8 * s + 7]);
            pf[s] = __builtin_bit_cast(bf16x8_t, a); pf[2 + s] = __builtin_bit_cast(bf16x8_t, c);
        }
#pragma unroll
        for (int s = 0; s < 4; ++s) {
            const s16x4_t l0 = lds_tr16(Vb + vro + s * 1024), h0 = lds_tr16(Vb + vro + s * 1024 + 512);
            const s16x4_t l1 = lds_tr16(Vb + vro + 4096 + s * 1024), h1 = lds_tr16(Vb + vro + 4096 + s * 1024 + 512);
            const bf16x8_t v0 = (bf16x8_t){l0[0], l0[1], l0[2], l0[3], h0[0], h0[1], h0[2], h0[3]}, v1 = (bf16x8_t){l1[0], l1[1], l1[2], l1[3], h1[0], h1[1], h1[2], h1[3]};
            o0 = __builtin_amdgcn_mfma_f32_32x32x16_bf16(v0, pf[s], o0, 0, 0, 0);
            o1 = __builtin_amdgcn_mfma_f32_32x32x16_bf16(v1, pf[s], o1, 0, 0, 0);
        }
        asm volatile("s_waitcnt vmcnt(0)" ::: "memory");
        __syncthreads();
    }
    float l_run = lsum.x + lsum.y; l_run += shx(l_run, 32, lane);
    const float inv = 1.f / l_run;
    float ss = 0.f;
#pragma unroll
    for (int r = 0; r < 16; ++r) { o0[r] *= inv; o1[r] *= inv; ss += o0[r] * o0[r] + o1[r] * o1[r]; }
    ss += shx(ss, 32, lane);
    LAS float* xs = (LAS float*)(lds + 131072);
    if (hl == 0) xs[(rb * 4 + h) * 32 + q] = ss;
    __syncthreads();
    const float tot = xs[(rb * 4 + 0) * 32 + q] + xs[(rb * 4 + 1) * 32 + q] + xs[(rb * 4 + 2) * 32 + q] + xs[(rb * 4 + 3) * 32 + q];
    const float rn = rsqrtf(tot * (1.f / 256.f) + 1e-6f);
    bf16_t* orow = CAT + trow * D + 384 + h * 64;
#pragma unroll
    for (int r4 = 0; r4 < 4; ++r4) {
        const int d = 8 * r4 + 4 * hl;
        const f32x4 g0 = *(const f32x4*)(ng + h * 64 + d), g1 = *(const f32x4*)(ng + h * 64 + 32 + d);
        u32x2 w0, w1;
        w0.x = pk2(o0[4 * r4 + 0] * rn * g0.x, o0[4 * r4 + 1] * rn * g0.y); w0.y = pk2(o0[4 * r4 + 2] * rn * g0.z, o0[4 * r4 + 3] * rn * g0.w);
        w1.x = pk2(o1[4 * r4 + 0] * rn * g1.x, o1[4 * r4 + 1] * rn * g1.y); w1.y = pk2(o1[4 * r4 + 2] * rn * g1.z, o1[4 * r4 + 3] * rn * g1.w);
        *(u32x2*)(orow + d) = w0; *(u32x2*)(orow + 32 + d) = w1;
    }
}


constexpr int G3_KD = 0, G3_QD = 6144, G3_KHT = 12288, G3_V = 20480, G3_S16 = 32768, G3_RR = 41984, G3_BC = 54272, G3_PART = 66816, G3_GW = 68352, G3_DEC = 71616, G3_RED = 71872, G3_END = 72704;
template <bool FULL>
__device__ __forceinline__ void gla3_unit(int unit, int tid, LAS unsigned char* sm, const bf16_t* __restrict__ P, const float* __restrict__ gw, const float* __restrict__ gb, const float* __restrict__ ng,
                                          float* __restrict__ GSUM, bf16_t* __restrict__ CAT) {
    typedef LAS float (*a49_t)[49]; typedef LAS float (*a48_t)[48];
    a49_t bc = (a49_t)(sm + G3_BC); LAS float* part = (LAS float*)(sm + G3_PART); a48_t gwl = (a48_t)(sm + G3_GW); LAS float* dec = (LAS float*)(sm + G3_DEC); LAS float* red = (LAS float*)(sm + G3_RED);
    const int seg = unit & 15, h = (unit >> 4) & 3, b = unit >> 6;
    const int wave = __builtin_amdgcn_readfirstlane(tid >> 6), lane = tid & 63, hl = lane >> 5, l31 = lane & 31, i16 = lane & 15, c0 = 16 * ((lane >> 4) & 1);
    const int eb = wave % 3, xb = wave / 3;
    const int dl = 32 * xb + l31;
    GlaRaw cur; gla_load_raw<FULL>(cur, P, b * L + (seg * 8) * 64, h, tid);
    __syncthreads();
    for (int i = tid; i < 17 * 48; i += 512) { const int r = i / 48, j = i % 48; gwl[r][j] = (r < 16) ? gw[r * 192 + h * 48 + j] : gb[h * 48 + j]; }
    for (int i = tid; i < 16 * 64; i += 512) ((LAS bf16_t*)(sm + G3_KHT))[48 * 64 + i] = 0;
    f32x16_t sacc;
#pragma unroll
    for (int r = 0; r < 16; ++r) sacc[r] = 0.f;
    float pdec = 1.f;
    if (FULL && wave < 6 && dl < 48) {
        const float* base = GSUM + (size_t)(unit - seg) * 4672;
#pragma unroll 2
        for (int sp = 0; sp < seg; ++sp) {
            const float* su = base + (size_t)sp * 4672; const float pd = su[4608 + dl];
#pragma unroll
            for (int r4 = 0; r4 < 4; ++r4) { const float4 s4 = *(const float4*)(su + dl * 96 + 32 * eb + 8 * r4 + 4 * hl);
                sacc[4 * r4] = pd * sacc[4 * r4] + s4.x; sacc[4 * r4 + 1] = pd * sacc[4 * r4 + 1] + s4.y; sacc[4 * r4 + 2] = pd * sacc[4 * r4 + 2] + s4.z; sacc[4 * r4 + 3] = pd * sacc[4 * r4 + 3] + s4.w; }
        }
    }
    if (FULL && wave < 6) {
        if (dl < 48) {
#pragma unroll
            for (int r4 = 0; r4 < 4; ++r4) { u32x2 w; w.x = pk2(sacc[4 * r4], sacc[4 * r4 + 1]); w.y = pk2(sacc[4 * r4 + 2], sacc[4 * r4 + 3]);
                *(LAS u32x2*)(sm + G3_S16 + dl * 192 + (32 * eb + 8 * r4 + 4 * hl) * 2) = w; } }
    }
    for (int c = 0; c < 8; ++c) {
        const int t0 = b * L + (seg * 8 + c) * 64;
        GlaRaw nxt = cur;
        if (c < 7) gla_load_raw<FULL>(nxt, P, t0 + 64, h, tid);
        int tidc = tid; asm volatile("" : "+v"(tidc));
        const int rt = tidc >> 3, jg = tidc & 7;
        __syncthreads();
        {
            const unsigned lw[8] = {cur.l0.x, cur.l0.y, cur.l0.z, cur.l0.w, cur.l1.x, cur.l1.y, cur.l1.z, cur.l1.w};
            float a[6];
#pragma unroll
            for (int i = 0; i < 6; ++i) a[i] = gwl[16][6 * jg + i];
#pragma unroll
            for (int r = 0; r < 8; ++r) { const float x0 = __uint_as_float(lw[r] << 16), x1 = __uint_as_float(lw[r] & 0xffff0000u);
#pragma unroll
                for (int i = 0; i < 6; ++i) a[i] += x0 * gwl[2 * r][6 * jg + i] + x1 * gwl[2 * r + 1][6 * jg + i]; }
#pragma unroll
            for (int i = 0; i < 6; ++i) bc[rt][6 * jg + i] = log_sigmoid_fast(a[i]) * (1.f / 16.f);
        }
        __syncthreads();
        float loc[8]; const int cj = tidc % 48, cp = tidc / 48;
        if (tidc < 384) { float s = 0.f;
#pragma unroll
            for (int r = 0; r < 8; ++r) { s += bc[cp * 8 + r][cj]; loc[r] = s; }
            part[cp * 48 + cj] = s; }
        __syncthreads();
        if (tidc < 384) { float off = 0.f;
#pragma unroll
            for (int q = 0; q < 8; ++q) off += (q < cp) ? part[q * 48 + cj] : 0.f;
#pragma unroll
            for (int r = 0; r < 8; ++r) bc[cp * 8 + r][cj] = loc[r] + off; }
        __syncthreads();
        {
            float kd[6], qd[6];
#pragma unroll
            for (int i = 0; i < 6; ++i) {
                const int j = 6 * jg + i; const float bcv = bc[rt][j], bl = bc[63][j];
                const unsigned kw = (i >> 1) == 0 ? cur.k.x : (i >> 1) == 1 ? cur.k.y : cur.k.z; const float kv = (i & 1) ? __uint_as_float(kw & 0xffff0000u) : __uint_as_float(kw << 16);
                ((LAS bf16_t*)(sm + G3_KHT))[j * 64 + rt] = (bf16_t)f2bf(kv * fexp(bl - bcv));
                kd[i] = kv * fexp(-bcv);
                if (FULL) { const unsigned qw = (i >> 1) == 0 ? cur.q.x : (i >> 1) == 1 ? cur.q.y : cur.q.z; const float qv = (i & 1) ? __uint_as_float(qw & 0xffff0000u) : __uint_as_float(qw << 16);
                    qd[i] = qv * 0.14433756729740643f * fexp(bcv); }
            }
            if (FULL) {
#pragma unroll
                for (int i = 0; i < 3; ++i) { *(LAS unsigned*)(sm + G3_KD + rt * 96 + (6 * jg + 2 * i) * 2) = pk2(kd[2 * i], kd[2 * i + 1]); *(LAS unsigned*)(sm + G3_QD + rt * 96 + (6 * jg + 2 * i) * 2) = pk2(qd[2 * i], qd[2 * i + 1]); }
            }
            *(LAS u32x2*)(sm + G3_V + rt * 192 + (12 * jg) * 2) = cur.v0; *(LAS u32x2*)(sm + G3_V + rt * 192 + (12 * jg + 4) * 2) = cur.v1; *(LAS u32x2*)(sm + G3_V + rt * 192 + (12 * jg + 8) * 2) = cur.v2;
            if (FULL) { *(LAS u32x2*)(sm + G3_RR + rt * 192 + (12 * jg) * 2) = cur.r0; *(LAS u32x2*)(sm + G3_RR + rt * 192 + (12 * jg + 4) * 2) = cur.r1; *(LAS u32x2*)(sm + G3_RR + rt * 192 + (12 * jg + 8) * 2) = cur.r2; }
            if (tidc < 48) dec[tidc] = fexp(bc[63][tidc]);
        }
        __syncthreads();
        const int vro = (4 * hl + (i16 >> 2)) * 192 + (32 * eb + c0 + 4 * (i16 & 3)) * 2;
        if (FULL) {
            f32x16_t oacc;
#pragma unroll
            for (int r = 0; r < 16; ++r) oacc[r] = 0.f;
            if (wave < 6) {
#pragma unroll
                for (int sb = 0; sb < 2; ++sb) {
                    if (sb <= xb) {
                        f32x16_t at;
#pragma unroll
                        for (int r = 0; r < 16; ++r) at[r] = 0.f;
#pragma unroll
                        for (int ks = 0; ks < 3; ++ks) {
                            const bf16x8_t ka = *(const LAS bf16x8_t*)(sm + G3_KD + (32 * sb + l31) * 96 + (16 * ks + 8 * hl) * 2);
                            const bf16x8_t qb = *(const LAS bf16x8_t*)(sm + G3_QD + (32 * xb + l31) * 96 + (16 * ks + 8 * hl) * 2);
                            at = __builtin_amdgcn_mfma_f32_32x32x16_bf16(ka, qb, at, 0, 0, 0);
                        }
                        if (sb == xb) {
#pragma unroll
                            for (int r = 0; r < 16; ++r) { const int sl = (r & 3) + 8 * (r >> 2) + 4 * hl; at[r] = (sl <= l31) ? at[r] : 0.f; }
                        }
#pragma unroll
                        for (int s2 = 0; s2 < 2; ++s2) {
                            u32x4 pw; pw.x = pk2(at[8 * s2], at[8 * s2 + 1]); pw.y = pk2(at[8 * s2 + 2], at[8 * s2 + 3]); pw.z = pk2(at[8 * s2 + 4], at[8 * s2 + 5]); pw.w = pk2(at[8 * s2 + 6], at[8 * s2 + 7]);
                            const LAS unsigned char* vp = sm + G3_V + vro + (2 * sb + s2) * 3072;
                            const s16x4_t lo = lds_tr16(vp), hi = lds_tr16(vp + 1536);
                            const bf16x8_t va = (bf16x8_t){lo[0], lo[1], lo[2], lo[3], hi[0], hi[1], hi[2], hi[3]};
                            oacc = __builtin_amdgcn_mfma_f32_32x32x16_bf16(va, __builtin_bit_cast(bf16x8_t, pw), oacc, 0, 0, 0);
                        }
                    }
                }
#pragma unroll
                for (int ks = 0; ks < 3; ++ks) {
                    const LAS unsigned char* sp = sm + G3_S16 + vro + ks * 3072;
                    const s16x4_t lo = lds_tr16(sp), hi = lds_tr16(sp + 1536);
                    const bf16x8_t sa = (bf16x8_t){lo[0], lo[1], lo[2], lo[3], hi[0], hi[1], hi[2], hi[3]};
                    const u32x2 q0 = *(const LAS u32x2*)(sm + G3_QD + (32 * xb + l31) * 96 + (16 * ks + 4 * hl) * 2), q1 = *(const LAS u32x2*)(sm + G3_QD + (32 * xb + l31) * 96 + (16 * ks + 8 + 4 * hl) * 2);
                    const u32x4 qw = (u32x4){q0.x, q0.y, q1.x, q1.y};
                    oacc = __builtin_amdgcn_mfma_f32_32x32x16_bf16(sa, __builtin_bit_cast(bf16x8_t, qw), oacc, 0, 0, 0);
                }
                float ss = 0.f;
#pragma unroll
                for (int r = 0; r < 16; ++r) ss += oacc[r] * oacc[r];
                ss += shx(ss, 32, lane);
                if (hl == 0) red[(xb * 3 + eb) * 32 + l31] = ss;
            }
            __syncthreads();
            if (wave < 6) {
                const float tot = red[(xb * 3 + 0) * 32 + l31] + red[(xb * 3 + 1) * 32 + l31] + red[(xb * 3 + 2) * 32 + l31];
                const float rn = rsqrtf(tot * (1.f / 96.f) + 1e-6f);
                const int t = 32 * xb + l31;
#pragma unroll
                for (int r4 = 0; r4 < 4; ++r4) {
                    const int e0 = 32 * eb + 8 * r4 + 4 * hl;
                    const f32x4 g4 = *(const f32x4*)(ng + e0);
                    const u32x2 rw = *(const LAS u32x2*)(sm + G3_RR + t * 192 + e0 * 2);
                    const float r0 = __uint_as_float(rw.x << 16), r1 = __uint_as_float(rw.x & 0xffff0000u), r2 = __uint_as_float(rw.y << 16), r3 = __uint_as_float(rw.y & 0xffff0000u);
                    u32x2 w; w.x = pk2(oacc[4 * r4] * rn * g4.x * siluf(r0), oacc[4 * r4 + 1] * rn * g4.y * siluf(r1)); w.y = pk2(oacc[4 * r4 + 2] * rn * g4.z * siluf(r2), oacc[4 * r4 + 3] * rn * g4.w * siluf(r3));
                    *(u32x2*)(CAT + (size_t)(t0 + t) * D + h * 96 + e0) = w;
                }
            }
        }
        if (wave < 6) {
            const float dd = dec[dl < 48 ? dl : 0];
            pdec *= dd;
#pragma unroll
            for (int r = 0; r < 16; ++r) sacc[r] *= dd;
#pragma unroll
            for (int ks = 0; ks < 4; ++ks) {
                const LAS unsigned char* vp = sm + G3_V + vro + ks * 3072;
                const s16x4_t lo = lds_tr16(vp), hi = lds_tr16(vp + 1536);
                const bf16x8_t va = (bf16x8_t){lo[0], lo[1], lo[2], lo[3], hi[0], hi[1], hi[2], hi[3]};
                const u32x2 k0 = *(const LAS u32x2*)(sm + G3_KHT + dl * 128 + (16 * ks + 4 * hl) * 2), k1 = *(const LAS u32x2*)(sm + G3_KHT + dl * 128 + (16 * ks + 8 + 4 * hl) * 2);
                const u32x4 kw = (u32x4){k0.x, k0.y, k1.x, k1.y};
                sacc = __builtin_amdgcn_mfma_f32_32x32x16_bf16(va, __builtin_bit_cast(bf16x8_t, kw), sacc, 0, 0, 0);
            }
        }
        if (FULL) {
            __syncthreads();
            if (wave < 6 && dl < 48) {
#pragma unroll
                for (int r4 = 0; r4 < 4; ++r4) { u32x2 w; w.x = pk2(sacc[4 * r4], sacc[4 * r4 + 1]); w.y = pk2(sacc[4 * r4 + 2], sacc[4 * r4 + 3]);
                    *(LAS u32x2*)(sm + G3_S16 + dl * 192 + (32 * eb + 8 * r4 + 4 * hl) * 2) = w; } }
        }
        cur = nxt;
    }
    if (!FULL && wave < 6 && dl < 48) {
        float* su = GSUM + (size_t)unit * 4672;
#pragma unroll
        for (int r4 = 0; r4 < 4; ++r4) *(float4*)(su + dl * 96 + 32 * eb + 8 * r4 + 4 * hl) = make_float4(sacc[4 * r4], sacc[4 * r4 + 1], sacc[4 * r4 + 2], sacc[4 * r4 + 3]);
        if (eb == 0 && hl == 0) su[4608 + dl] = pdec;
    }
}

__device__ __forceinline__ void ph_norm2_router(LAS unsigned char* lds, const float* __restrict__ X, const float* __restrict__ g, const float* __restrict__ modl, const float* __restrict__ wg, const float* __restrict__ bg,
                                                const float* __restrict__ we, const float* __restrict__ be, bf16_t* __restrict__ HN, unsigned* __restrict__ cnt, int* __restrict__ EID, float* __restrict__ EW, int* __restrict__ SLOT,
                                                const int tid, const int bx, const int G) {
    LAS float* Wt = (LAS float*)lds;
    LAS float* lgs = (LAS float*)(lds + 36 * 1024 * 4);
    LAS unsigned* lcnt = (LAS unsigned*)(lgs + 8 * 80);
    const int wave = tid >> 6, lane = tid & 63;
    __syncthreads();
    if (tid < 64) lcnt[tid] = 0u;
#pragma unroll
    for (int i = tid; i < 1024 * 8; i += 512) { const int k = i & 1023, e4 = (i >> 10) * 4; const float4 w4 = *(const float4*)(we + k * 32 + e4);
        Wt[(4 + e4) * 1024 + k] = w4.x; Wt[(5 + e4) * 1024 + k] = w4.y; Wt[(6 + e4) * 1024 + k] = w4.z; Wt[(7 + e4) * 1024 + k] = w4.w; }
#pragma unroll
    for (int k = tid; k < 1024; k += 512) { const float4 w4 = *(const float4*)(wg + k * 4); Wt[k] = w4.x; Wt[1024 + k] = w4.y; Wt[2048 + k] = w4.z; Wt[3072 + k] = w4.w; }
    __syncthreads();
    LAS float* lg = lgs + wave * 80;
    int ridx[2]; bool rok[2];
#pragma unroll
    for (int i = 0; i < 2; ++i) {
        int x = i + 2 * (lane & 1); bool ok = x < 3;
        x += 3 * ((lane >> 1) & 1); ok = ok && x < 5;
        x += 5 * ((lane >> 2) & 1); ok = ok && x < 9;
        x += 9 * ((lane >> 3) & 1); x += 18 * ((lane >> 4) & 1); x += 36 * ((lane >> 5) & 1);
        ridx[i] = (x / 36) * 40 + (x % 36); rok[i] = ok;
    }
    float bias2[2];
#pragma unroll
    for (int i = 0; i < 2; ++i) { const int j = ridx[i] % 40; bias2[i] = rok[i] ? (j < 4 ? bg[j] : be[j - 4]) : 0.f; }
    for (int t0 = (bx * NWAVES + wave) * 2; t0 < T; t0 += G * NWAVES * 2) {
        const int b = t0 / L;
        f32x4 hv[2][4];
#pragma unroll
        for (int q = 0; q < 2; ++q) {
            const float* xr = X + (size_t)(t0 + q) * D;
#pragma unroll
            for (int i = 0; i < 4; ++i) hv[q][i] = *(const f32x4*)(xr + 4 * lane + 256 * i);
        }
        f32x4 gg[4], sc[4], sh[4];
#pragma unroll
        for (int i = 0; i < 4; ++i) { const int col = 4 * lane + 256 * i; gg[i] = *(const f32x4*)(g + col); sc[i] = *(const f32x4*)(modl + b * 6144 + 4096 + col); sh[i] = *(const f32x4*)(modl + b * 6144 + 3072 + col); }
#pragma unroll
        for (int q = 0; q < 2; ++q) {
            float ss = 0.f;
#pragma unroll
            for (int i = 0; i < 4; ++i) ss += hv[q][i].x * hv[q][i].x + hv[q][i].y * hv[q][i].y + hv[q][i].z * hv[q][i].z + hv[q][i].w * hv[q][i].w;
            ss = wave_sum(ss, lane);
            const float r = rsqrtf(ss * (1.f / D) + 1e-6f);
#pragma unroll
            for (int i = 0; i < 4; ++i) { const int col = 4 * lane + 256 * i;
                hv[q][i] = hv[q][i] * r * gg[i] * (sc[i] + 1.f) + sh[i];
                u32x2 o; o.x = pk2(hv[q][i].x, hv[q][i].y); o.y = pk2(hv[q][i].z, hv[q][i].w);
                *(u32x2*)(HN + (size_t)(t0 + q) * D + col) = o; }
        }
        float v[72];
#pragma unroll
        for (int j = 0; j < 36; ++j) {
            float a0 = 0.f, a1 = 0.f;
#pragma unroll
            for (int i = 0; i < 4; ++i) { const f32x4 w4 = *(const LAS f32x4*)(Wt + j * 1024 + 4 * lane + 256 * i);
                a0 += hv[0][i].x * w4.x + hv[0][i].y * w4.y + hv[0][i].z * w4.z + hv[0][i].w * w4.w;
                a1 += hv[1][i].x * w4.x + hv[1][i].y * w4.y + hv[1][i].z * w4.z + hv[1][i].w * w4.w; }
            v[j] = a0; v[36 + j] = a1;
        }
#define RSTEP(N_, H_, BIT_) do { const bool up_ = (lane & (BIT_)) != 0; _Pragma("unroll") for (int i = 0; i < (H_); ++i) { const float lo_ = v[i], hi_ = (i + (H_) < (N_)) ? v[i + (H_)] : 0.f; \
            const float keep_ = up_ ? hi_ : lo_, send_ = up_ ? lo_ : hi_; v[i] = keep_ + shx(send_, (BIT_), lane); } } while (0)
        RSTEP(72, 36, 32); RSTEP(36, 18, 16); RSTEP(18, 9, 8); RSTEP(9, 5, 4); RSTEP(5, 3, 2); RSTEP(3, 2, 1);
#undef RSTEP
        if (rok[0]) lg[ridx[0]] = v[0] + bias2[0];
        if (rok[1]) lg[ridx[1]] = v[1] + bias2[1];
        asm volatile("s_waitcnt lgkmcnt(0)" ::: "memory");
        if (lane < 2) {
            const LAS float* lq = lg + 40 * lane; const int t = t0 + lane;
            float gm = lq[0]; int gi = 0;
            for (int q = 1; q < 4; ++q) if (lq[q] > gm) { gm = lq[q]; gi = q; }
            float gs = 0.f; for (int q = 0; q < 4; ++q) gs += fexp(lq[q] - gm);
            const float gp = 1.f / gs;
            const LAS float* le = lq + 4 + gi * 8;
            int j1 = 0; float l1 = le[0];
            for (int j = 1; j < 8; ++j) if (le[j] > l1) { l1 = le[j]; j1 = j; }
            int j2 = -1; float l2 = -INFINITY;
            for (int j = 0; j < 8; ++j) if (j != j1 && le[j] > l2) { l2 = le[j]; j2 = j; }
            const float e2 = fexp(l2 - l1), den = 1.f + e2;
            const int ea = gi * 8 + j1, eb = gi * 8 + j2;
            EID[2 * t] = ea; EID[2 * t + 1] = eb;
            EW[2 * t] = gp / den; EW[2 * t + 1] = gp * e2 / den;
            SLOT[2 * t] = (int)__hip_atomic_fetch_add(&lcnt[ea], 1u, __ATOMIC_RELAXED, __HIP_MEMORY_SCOPE_WORKGROUP); SLOT[2 * t + 1] = (int)__hip_atomic_fetch_add(&lcnt[eb], 1u, __ATOMIC_RELAXED, __HIP_MEMORY_SCOPE_WORKGROUP);
        }
        asm volatile("s_waitcnt lgkmcnt(0)" ::: "memory");
    }
    asm volatile("s_waitcnt vmcnt(0)" ::: "memory");
    __syncthreads();
    if (tid < NE) lcnt[32 + tid] = atomicAdd(&cnt[64 * tid], lcnt[tid]);
    __syncthreads();
    for (int t0 = (bx * NWAVES + wave) * 2; t0 < T; t0 += G * NWAVES * 2)
        if (lane < 4) { const int i = 2 * t0 + lane; SLOT[i] += (int)lcnt[32 + EID[i]]; }
}
__device__ __forceinline__ void ph_moe_scatter(LAS unsigned* pl, unsigned* __restrict__ cnt, const int* __restrict__ EID, const int* __restrict__ SLOT, int* __restrict__ POS, int* __restrict__ TOK, const int tid, const int bx, const int G) {
    unsigned* plan = cnt + 4096;
    __syncthreads();
    if (tid == 0) {
        unsigned ts = 0;
#pragma unroll 1
        for (int e = 0; e < NE; ++e) { pl[e] = ts; const unsigned c = __builtin_nontemporal_load(cnt + 64 * e); const unsigned nt = (c + 255u) / 256u;
            if (bx == 0) { plan[32 + e] = ts;
#pragma unroll 1
                for (unsigned q = 0; q < nt; ++q) plan[128 + ts + q] = (unsigned)e; }
            ts += nt; }
        pl[NE] = ts; if (bx == 0) { plan[32 + NE] = ts; plan[72] = ts; }
    }
    __syncthreads();
    for (int i = bx * 512 + tid; i < 2 * T; i += G * 512) {
        const int pos = (int)pl[EID[i]] * 256 + SLOT[i];
        POS[i] = pos; TOK[pos] = i >> 1;
    }
}
template <bool FINAL>
__device__ __forceinline__ void ph_moe_combine(float* __restrict__ X, const bf16_t* __restrict__ OUTR, const int* __restrict__ POS, const float* __restrict__ EW, const float* __restrict__ modl,
                                               const float* __restrict__ g, const float* __restrict__ modn, bf16_t* __restrict__ HN, const int tid, const int bx, const int G) {
    const int wave = tid >> 6, lane = tid & 63;
    const int st = G * NWAVES;
    int t = bx * NWAVES + wave;
    int p0n = 0, p1n = 0; float w0n = 0.f, w1n = 0.f;
    u32x2 an0, an1, an2, an3, cn0, cn1, cn2, cn3; f32x4 xn0, xn1, xn2, xn3; float w0c = 0.f, w1c = 0.f;
    an0 = an1 = an2 = an3 = cn0 = cn1 = cn2 = cn3 = (u32x2){0u, 0u}; xn0 = xn1 = xn2 = xn3 = (f32x4){0.f, 0.f, 0.f, 0.f};
#define CMB_ROWS(tt_, q0_, q1_) do { const bf16_t* o0_ = OUTR + (size_t)(q0_) * 1024 + 4 * lane; const bf16_t* o1_ = OUTR + (size_t)(q1_) * 1024 + 4 * lane; const float* xr_ = X + (size_t)(tt_) * D + 4 * lane; \
        an0 = *(const u32x2*)(o0_); an1 = *(const u32x2*)(o0_ + 256); an2 = *(const u32x2*)(o0_ + 512); an3 = *(const u32x2*)(o0_ + 768); \
        cn0 = *(const u32x2*)(o1_); cn1 = *(const u32x2*)(o1_ + 256); cn2 = *(const u32x2*)(o1_ + 512); cn3 = *(const u32x2*)(o1_ + 768); \
        xn0 = *(const f32x4*)(xr_); xn1 = *(const f32x4*)(xr_ + 256); xn2 = *(const f32x4*)(xr_ + 512); xn3 = *(const f32x4*)(xr_ + 768); } while (0)
    if (t < T) { const int q0 = POS[2 * t], q1 = POS[2 * t + 1]; w0c = EW[2 * t]; w1c = EW[2 * t + 1]; CMB_ROWS(t, q0, q1); }
    if (t + st < T) { p0n = POS[2 * (t + st)]; p1n = POS[2 * (t + st) + 1]; w0n = EW[2 * (t + st)]; w1n = EW[2 * (t + st) + 1]; }
    for (; t < T; t += st) {
        const int b = t / L;
        const float w0 = w0c, w1 = w1c;
        const u32x2 av[4] = {an0, an1, an2, an3}, cv[4] = {cn0, cn1, cn2, cn3};
        f32x4 xv[4] = {xn0, xn1, xn2, xn3};
        float* xr = X + (size_t)t * D;
        if (t + st < T) { w0c = w0n; w1c = w1n; CMB_ROWS(t + st, p0n, p1n); }
        if (t + 2 * st < T) { p0n = POS[2 * (t + 2 * st)]; p1n = POS[2 * (t + 2 * st) + 1]; w0n = EW[2 * (t + 2 * st)]; w1n = EW[2 * (t + 2 * st) + 1]; }
        float ss = 0.f;
#pragma unroll
        for (int i = 0; i < 4; ++i) {
            const int col = 4 * lane + 256 * i;
            const float4 a = (float4){__uint_as_float(av[i].x << 16), __uint_as_float(av[i].x & 0xffff0000u), __uint_as_float(av[i].y << 16), __uint_as_float(av[i].y & 0xffff0000u)};
            const float4 c = (float4){__uint_as_float(cv[i].x << 16), __uint_as_float(cv[i].x & 0xffff0000u), __uint_as_float(cv[i].y << 16), __uint_as_float(cv[i].y & 0xffff0000u)};
            const f32x4 g4 = *(const f32x4*)(modl + b * 6144 + 5120 + col);
            xv[i].x += g4.x * (w0 * a.x + w1 * c.x); xv[i].y += g4.y * (w0 * a.y + w1 * c.y); xv[i].z += g4.z * (w0 * a.z + w1 * c.z); xv[i].w += g4.w * (w0 * a.w + w1 * c.w);
            ss += xv[i].x * xv[i].x + xv[i].y * xv[i].y + xv[i].z * xv[i].z + xv[i].w * xv[i].w;
        }
        ss = wave_sum(ss, lane);
        const float r = rsqrtf(ss * (1.f / D) + 1e-6f);
#pragma unroll
        for (int i = 0; i < 4; ++i) {
            const int col = 4 * lane + 256 * i;
            const f32x4 gg = *(const f32x4*)(g + col);
            if (FINAL) { *(f32x4*)(xr + col) = xv[i] * r * gg; }
            else {
                *(f32x4*)(xr + col) = xv[i];
                const f32x4 sc = *(const f32x4*)(modn + b * 6144 + 1024 + col), sh = *(const f32x4*)(modn + b * 6144 + col);
                const f32x4 y = xv[i] * r * gg * (sc + 1.f) + sh;
                u32x2 o; o.x = pk2(y.x, y.y); o.y = pk2(y.z, y.w);
                *(u32x2*)(HN + (size_t)t * D + col) = o;
            }
        }
    }
}

#undef CMB_ROWS
#define XB_TMO      128
#define XB_XCNT(j)  (256  + 64 * (j))
#define XB_XSUB(j)  (1280 + 64 * (j))
#define XB_XGEN(j)  (2304 + 64 * (j))
#define XB_TOP      3328
#define XB_TOPGEN   3392
#define XCD_BAR_WORDS 3456
#define XB_SPIN_CAP (1u << 18)

__device__ __forceinline__ unsigned xb_ld(unsigned* p)              { return __hip_atomic_load(p, __ATOMIC_RELAXED, __HIP_MEMORY_SCOPE_AGENT); }
__device__ __forceinline__ unsigned xb_add(unsigned* p, unsigned v) { return __hip_atomic_fetch_add(p, v, __ATOMIC_RELAXED, __HIP_MEMORY_SCOPE_AGENT); }
__device__ __forceinline__ unsigned xb_xcc_id() { return (unsigned)__builtin_amdgcn_s_getreg((3 << 11) | 20) & 0xFu; }
#define XB_SPIN(cond, bar) do { unsigned _sp = 0; while (cond) { __builtin_amdgcn_s_sleep(1); \
    if ((++_sp & 255u) == 0u) { if (xb_ld(&(bar)[XB_TMO])) break; if (_sp > XB_SPIN_CAP) { atomicAdd(&(bar)[XB_TMO], 1u); break; } } } } while (0)

struct XcdBarrier {
    unsigned* bar; unsigned x;
    volatile LAS unsigned* st;
};

__device__ __forceinline__ XcdBarrier xcd_barrier_post(unsigned* bar, volatile LAS unsigned* st, const int tid) {
    XcdBarrier b; b.bar = bar; b.x = xb_xcc_id(); b.st = st;
    if (tid == 0) (void)xb_add(&bar[XB_XCNT(b.x)], 1u);
    return b;
}
__device__ __forceinline__ void xcd_barrier_complete(unsigned* bar, unsigned x, unsigned& nloc, unsigned& nx) {
    const unsigned G = gridDim.x * gridDim.y * gridDim.z;
    unsigned sum, cnt, mine, sp = 0u;
    for (;;) {
        sum = 0u; cnt = 0u; mine = 0u;
#pragma unroll
        for (unsigned j = 0; j < 16; ++j) { const unsigned c = xb_ld(&bar[XB_XCNT(j)]); sum += c; cnt += (c > 0u) ? 1u : 0u; mine = (j == x) ? c : mine; }
        if (sum == G) break;
        __builtin_amdgcn_s_sleep(1);
        if ((++sp & 255u) == 0u) { if (xb_ld(&bar[XB_TMO])) break; if (sp > XB_SPIN_CAP) { atomicAdd(&bar[XB_TMO], 1u); break; } }
    }
    nloc = mine > 0u ? mine : 1u; nx = cnt > 0u ? cnt : 1u;
}

__device__ __forceinline__ void xcd_barrier(const XcdBarrier& b, const int tid) {
    asm volatile("s_waitcnt vmcnt(0)" ::: "memory");
    __syncthreads();
    if (tid == 0) {
        unsigned* bar = b.bar;
        __builtin_amdgcn_s_waitcnt(0);
        unsigned nloc = b.st[0], nx = b.st[1];
        if (nloc == 0u) { xcd_barrier_complete(bar, b.x, nloc, nx); b.st[0] = nloc; b.st[1] = nx; }
        const unsigned old = xb_add(&bar[XB_XSUB(b.x)], 1u);
        const unsigned gen = old / nloc;
        if (old + 1u == (gen + 1u) * nloc) {
            __builtin_amdgcn_fence(__ATOMIC_RELEASE, "agent");
            asm volatile("s_waitcnt vmcnt(0)" ::: "memory");
            const unsigned og = xb_add(&bar[XB_TOP], 1u);
            const unsigned tg = og / nx;
            if (og + 1u == (tg + 1u) * nx) xb_add(&bar[XB_TOPGEN], 1u);
            else XB_SPIN(xb_ld(&bar[XB_TOPGEN]) == tg, bar);
            __builtin_amdgcn_fence(__ATOMIC_ACQUIRE, "agent");
            xb_add(&bar[XB_XGEN(b.x)], 1u);
            asm volatile("s_waitcnt vmcnt(0)" ::: "memory");
        } else {
            XB_SPIN(xb_ld(&bar[XB_XGEN(b.x)]) == gen, bar);
            __builtin_amdgcn_fence(__ATOMIC_ACQUIRE, "agent");
            asm volatile("s_waitcnt vmcnt(0)" ::: "memory");
        }
    }
    __syncthreads();
}

constexpr int LDS_BYTES = 160 * 1024;
__global__ void __launch_bounds__(512, 2) k_mega(Params p) {
    extern __shared__ __attribute__((aligned(16))) unsigned char lds_raw[];
    LAS unsigned char* lds = (LAS unsigned char*)lds_raw;
    cg::grid_group grid = cg::this_grid();
    if (threadIdx.x < 2) ((volatile LAS unsigned*)(lds + 163832))[threadIdx.x] = 0u;
    __syncthreads();
    const int wave_s = __builtin_amdgcn_readfirstlane((int)threadIdx.x >> 6);
#define PH int tid, bx = (int)blockIdx.x, G = (int)gridDim.x; asm volatile("v_mbcnt_lo_u32_b32 %0, -1, 0\n\tv_mbcnt_hi_u32_b32 %0, -1, %0\n\tv_lshl_add_u32 %0, %3, 6, %0" : "=&v"(tid), "+s"(bx), "+s"(G) : "s"(wave_s)); const int wave = tid >> 6, lane = tid & 63, half = tid >> 8, htid = tid & 255; (void)wave; (void)lane; (void)half; (void)htid;
    const unsigned long long kbase = (unsigned long long)__builtin_amdgcn_kernarg_segment_ptr();
#define KPTR(off) ({ unsigned long long r_; asm volatile("s_load_dwordx2 %0, %1, %2\n\ts_waitcnt lgkmcnt(0)" : "=s"(r_) : "s"(kbase), "i"(off) : "memory"); r_; })
#define KGAS __attribute__((address_space(1)))
#define KIN(i) ((const float*)(const KGAS float*)KPTR(8 * (i)))
#define KOUT ((float*)(KGAS float*)KPTR(248))
#define KWS ((unsigned char*)(KGAS unsigned char*)KPTR(256))
#define GSYNC() do { asm volatile("; === GSYNC %0" :: "i"(__LINE__)); { PH XcdBarrier xb_; xb_.bar = (unsigned*)(KWS + OFF_CTL); xb_.x = xb_xcc_id(); xb_.st = (volatile LAS unsigned*)(lds + 163832); xcd_barrier(xb_, tid); } } while (0)

    { PH (void)xcd_barrier_post((unsigned*)(KWS + OFF_CTL), (volatile LAS unsigned*)(lds + 163832), tid); }
#pragma clang loop unroll(disable)
    for (int l = 0; l < 2; ++l) {
        if (l == 0) {
            { PH ProArgs pa; pa.c = KIN(1); pa.ada_w = KIN(2); pa.ada_b = KIN(3); pa.w_in = KIN(5); pa.w_out = KIN(21); pa.glu_w = KIN(18);
              pa.wgate = KIN(27); pa.wup = KIN(28); pa.wdown = KIN(29); pa.ws = KWS; pa.do_small = 1; pa.pad = 0;
              ph_prologue(pa, lds, tid, bx, G);
              if (bx == 0) for (int i = tid; i < 2048; i += 512) ((unsigned*)(pa.ws + OFF_CNT))[i] = 0u; }
            grid.sync();
            { PH unsigned char* ws = KWS;
              ph_norm1(KIN(0), KIN(4), (const float*)(ws + OFF_MOD), (bf16_t*)(ws + OFF_HN), tid, bx, G); }
            GSYNC();
        }
        { PH unsigned char* ws = KWS;
          pg8::Gemm g; g.A = (bf16_t*)(ws + OFF_HN); g.Bt = (bf16_t*)(ws + OFF_W + W_WIN) + (size_t)l * PL * D; g.M = T; g.N = 2560; g.K = D; pg8::StaticOrder S; S.init(T, 2560, G, bx);
          EpiProj E; E.O = (bf16_t*)(ws + OFF_C); E.IKC = (bf16_t*)(ws + OFF_E + E_IKC);
          pg8::gemm_phase<EpiProj, pg8::StaticOrder, true, true>(lds, g, S, E, tid); }
        GSYNC();
        { PH unsigned char* ws = KWS; const bf16_t* PROJ = (const bf16_t*)(ws + OFF_C);
          const float* gw = KIN(6) + l * 16 * 192; const float* gb = KIN(7) + l * 192;
          float* GSUM = (float*)(ws + OFF_E + E_UPD);
          for (int u = bx; u < 256; u += G) gla3_unit<false>(u, tid, lds, PROJ, gw, gb, nullptr, GSUM, nullptr);
          const float *are = KIN(10) + l * 1536, *aim = KIN(11) + l * 1536, *lst = KIN(12) + l * 24, *bre = KIN(13) + l * 24576, *bim = KIN(14) + l * 24576;
          float* S5E = (float*)(ws + OFF_E + E_S5E);
          for (int u = bx; u < 256; u += G) s5_unit<false>(u, tid, lds, PROJ, are, aim, lst, bre, bim, nullptr, nullptr, nullptr, S5E, nullptr, nullptr, nullptr, nullptr, (const bf16_t*)(ws + OFF_HN), (const bf16_t*)(ws + OFF_W + W_WIN) + ((size_t)l * PL + 2560) * D, (bf16_t*)(ws + OFF_C));
        }
        GSYNC();
        { PH unsigned char* ws = KWS; const bf16_t* PROJ = (const bf16_t*)(ws + OFF_C); bf16_t* CAT = (bf16_t*)(ws + OFF_D);
          const float* gw = KIN(6) + l * 16 * 192; const float* gb = KIN(7) + l * 192; float* GSUM = (float*)(ws + OFF_E + E_UPD); const float* gng = KIN(8) + l * 96;
          for (int u = bx; u < 256; u += G) gla3_unit<true>(u, tid, lds, PROJ, gw, gb, gng, GSUM, CAT);
          __syncthreads(); }
        { PH unsigned char* ws = KWS; const bf16_t* PROJ = (const bf16_t*)(ws + OFF_C); bf16_t* CAT = (bf16_t*)(ws + OFF_D);
          const float *are = KIN(10) + l * 1536, *aim = KIN(11) + l * 1536, *lst = KIN(12) + l * 24, *bre = KIN(13) + l * 24576, *bim = KIN(14) + l * 24576;
          const float *cre = KIN(15) + l * 24576, *cim = KIN(16) + l * 24576, *sd = KIN(17) + l * 384;
          float* S5E = (float*)(ws + OFF_E + E_S5E); const float *glb = KIN(19) + l * 384, *sng = KIN(20) + l * 384; const bf16_t* GLUT = (const bf16_t*)(ws + OFF_W + W_GLU) + (size_t)l * 384 * 384;
          for (int u = bx; u < 256; u += G) s5_unit<true>(u, tid, lds, PROJ, are, aim, lst, bre, bim, cre, cim, sd, S5E, GLUT, glb, sng, CAT);
          __syncthreads(); }
        { PH unsigned char* ws = KWS; const bf16_t* PROJ = (const bf16_t*)(ws + OFF_C);
          unsigned long long* MASK = (unsigned long long*)(ws + OFF_E + E_MASK);
          const bf16_t* IKC = (const bf16_t*)(ws + OFF_E + E_IKC);
          const bool serp = ((T / 8) % G) == 0;
          __syncthreads();
          tk5_prefetch(bx, lds, PROJ, tid);
          for (int vb = bx, rnd = 0; vb < T / 8; vb += G, ++rnd) {
              int tid_u; asm volatile("v_mbcnt_lo_u32_b32 %0, -1, 0\n\tv_mbcnt_hi_u32_b32 %0, -1, %0\n\tv_lshl_add_u32 %0, %1, 6, %0" : "=&v"(tid_u) : "s"(wave_s));
              const int uu = (serp && (rnd & 1)) ? rnd * G + (G - 1 - bx) : vb;
              const int vn = vb + G, un = vn < T / 8 ? ((serp && ((rnd + 1) & 1)) ? (rnd + 1) * G + (G - 1 - bx) : vn) : -1;
              topk5_unit(uu, un, lds, PROJ, IKC, MASK, tid_u); } }
        GSYNC();
        { PH unsigned char* ws = KWS; const bf16_t* PROJ = (const bf16_t*)(ws + OFF_C); bf16_t* CAT = (bf16_t*)(ws + OFF_D);
          __syncthreads();
          { const unsigned long long* MASK = (const unsigned long long*)(ws + OFF_E + E_MASK); const float* dng = KIN(9) + l * 256;
            for (int pi0 = bx; pi0 < 256; pi0 += G) {
                const int pi = (G == 256) ? ((pi0 & 7) >> 1) * 64 + (pi0 & 1) * 32 + (pi0 >> 3) : pi0;
                const int bb = pi >> 6, jq = pi & 63;
                dsa_attn_unit(bb, 127 - jq, lds, PROJ, MASK, dng, CAT, tid);
                dsa_attn_unit(bb, jq, lds, PROJ, MASK, dng, CAT, tid); } }
        }
        GSYNC();
        { PH unsigned char* ws = KWS;
          pg8::Gemm g; g.A = (bf16_t*)(ws + OFF_D); g.Bt = (bf16_t*)(ws + OFF_W + W_WOUT) + (size_t)l * D * D; g.M = T; g.N = D; g.K = D; pg8::StaticOrder S; S.init(T, D, G, bx);
          EpiRes E; E.xin = (l == 0) ? KIN(0) : KOUT; E.xout = KOUT; E.gt = (const float*)(ws + OFF_MOD) + (size_t)l * 4 * 6144 + 2048;
          pg8::gemm_phase<EpiRes, pg8::StaticOrder, true, true>(lds, g, S, E, tid); }
        GSYNC();
        { PH unsigned char* ws = KWS; const float* X = KOUT; const float* modl = (const float*)(ws + OFF_MOD) + (size_t)l * 4 * 6144;
          const float *n2g = KIN(22) + l * D, *rgw = KIN(23) + l * 4096, *rgb = KIN(24) + l * 4, *rew = KIN(25) + l * 32768, *reb = KIN(26) + l * 32;
          for (int i = bx * 512 + tid; i < MAXTILES * 256; i += G * 512) ((int*)(ws + OFF_TOK))[i] = 0;
          ph_norm2_router(lds, X, n2g, modl, rgw, rgb, rew, reb, (bf16_t*)(ws + OFF_HN), (unsigned*)(ws + OFF_CNT), (int*)(ws + OFF_EID), (float*)(ws + OFF_EW), (int*)(ws + OFF_SLOT), tid, bx, G); }
        GSYNC();
        { PH unsigned char* ws = KWS;
          ph_moe_scatter((LAS unsigned*)lds, (unsigned*)(ws + OFF_CNT), (const int*)(ws + OFF_EID), (const int*)(ws + OFF_SLOT), (int*)(ws + OFF_POS), (int*)(ws + OFF_TOK), tid, bx, G); }
        GSYNC();
        { PH unsigned char* ws = KWS;
          pg8::Gemm g; g.A = (bf16_t*)(ws + OFF_HN); g.tok = (const int*)(ws + OFF_TOK); g.Bt = (bf16_t*)(ws + OFF_W + W_EGU); g.M = MAXTILES * 256; g.N = 1024; g.K = 1024; MoeOrder S; S.plan = (const unsigned*)(ws + OFF_CNT) + 4096; S.nN = 4; S.estride = (long)1024 * 1024 * 2; S.init(G, bx);
          EpiGU E; E.HID = (bf16_t*)(ws + OFF_E);
          pg8::gemm_phase<EpiGU, MoeOrder, true, true, true>(lds, g, S, E, tid); }
        GSYNC();
        { PH unsigned char* ws = KWS;
          pg8::Gemm g; g.A = (bf16_t*)(ws + OFF_E); g.Bt = (bf16_t*)(ws + OFF_W + W_EDN); g.M = MAXTILES * 256; g.N = 1024; g.K = 512; MoeOrder S; S.plan = (const unsigned*)(ws + OFF_CNT) + 4096; S.nN = 4; S.estride = (long)1024 * 512 * 2; S.init(G, bx);
          pg8::EpiBf16<0> E; E.O = (bf16_t*)(ws + OFF_D); E.ldc = 1024; E.bias = nullptr; E.split_cols = 0; E.split_stride = 0; E.scale0 = 1.f;
          pg8::gemm_phase<pg8::EpiBf16<0>, MoeOrder, true, true>(lds, g, S, E, tid); }
        GSYNC();
        if (l == 0) {
            { PH unsigned char* ws = KWS;
              ph_moe_combine<false>(KOUT, (const bf16_t*)(ws + OFF_D), (const int*)(ws + OFF_POS), (const float*)(ws + OFF_EW), (const float*)(ws + OFF_MOD), KIN(4) + D, (const float*)(ws + OFF_MOD) + 4 * 6144, (bf16_t*)(ws + OFF_HN), tid, bx, G); }
            { PH ProArgs pa; pa.c = nullptr; pa.ada_w = nullptr; pa.ada_b = nullptr; pa.w_in = nullptr; pa.w_out = nullptr; pa.glu_w = nullptr;
              pa.wgate = KIN(27) + (size_t)32 * 1024 * 512; pa.wup = KIN(28) + (size_t)32 * 1024 * 512; pa.wdown = KIN(29) + (size_t)32 * 512 * 1024; pa.ws = KWS; pa.do_small = 0; pa.pad = 0;
              ph_prologue(pa, lds, tid, bx, G);
              if (bx == 0) for (int i = tid; i < 2048; i += 512) ((unsigned*)(pa.ws + OFF_CNT))[i] = 0u; }
            GSYNC();
        } else {
            PH unsigned char* ws = KWS;
            ph_moe_combine<true>(KOUT, (const bf16_t*)(ws + OFF_D), (const int*)(ws + OFF_POS), (const float*)(ws + OFF_EW), (const float*)(ws + OFF_MOD) + 4 * 6144, KIN(30), nullptr, nullptr, tid, bx, G);
        }
    }
}
}

extern "C" void kernel_launch(void* const* d_in, const int* in_sizes, int n_in, void* d_out, int out_size, void* d_ws, size_t ws_size, hipStream_t stream) {
    static int grid_blocks = 0;
    if (grid_blocks == 0) {
        if (n_in != 31 || in_sizes[0] != T * D || out_size != T * D || ws_size < WS_NEED) { fprintf(stderr, "kernel_launch: unexpected shapes / workspace (%d inputs, ws %zu need %zu)\n", n_in, ws_size, (size_t)WS_NEED); grid_blocks = -1; return; }
        int dev = 0, cus = 0, per_cu = 0;
        if (hipGetDevice(&dev) != hipSuccess || hipDeviceGetAttribute(&cus, hipDeviceAttributeMultiprocessorCount, dev) != hipSuccess) { grid_blocks = -1; return; }
        if (hipFuncSetAttribute((const void*)k_mega, hipFuncAttributeMaxDynamicSharedMemorySize, LDS_BYTES) != hipSuccess) { fprintf(stderr, "hipFuncSetAttribute failed\n"); grid_blocks = -1; return; }
        if (hipOccupancyMaxActiveBlocksPerMultiprocessor(&per_cu, (const void*)k_mega, 512, LDS_BYTES) != hipSuccess || per_cu < 1) { fprintf(stderr, "occupancy query: %d blocks per CU\n", per_cu); grid_blocks = -1; return; }
        grid_blocks = cus;
    }
    if (grid_blocks < 0) return;
    if (hipMemsetAsync((char*)d_ws + OFF_CTL, 0, 16384, stream) != hipSuccess) { fprintf(stderr, "hipMemsetAsync failed\n"); return; }
    Params p; memset((void*)&p, 0, sizeof(p));
    for (int i = 0; i < 31; ++i) p.in[i] = (const float*)d_in[i];
    p.out = (float*)d_out; p.ws = (unsigned char*)d_ws;
    void* args[] = {&p};
    hipError_t e = hipLaunchCooperativeKernel((const void*)k_mega, dim3(grid_blocks), dim3(512), args, LDS_BYTES, stream);
    if (e != hipSuccess) fprintf(stderr, "cooperative launch failed: %s (grid %d)\n", hipGetErrorString(e), grid_blocks);
}
```

```cpp
#include <hip/hip_runtime.h>
#include <hip/hip_cooperative_groups.h>
#include <cstdio>
#include <cstdint>
#include <cmath>
#include <cstring>
namespace cg = cooperative_groups;
namespace pg8 {
#define PG8_LAS __attribute__((address_space(3)))
typedef unsigned short bf16_t;
typedef short bf16x8 __attribute__((ext_vector_type(8)));
typedef float f32x4 __attribute__((ext_vector_type(4)));
typedef unsigned u32x4 __attribute__((ext_vector_type(4)));
constexpr int BM = 256, BK = 64, HALF = 128, HTB = HALF * BK * 2  , STAGE_BYTES = 8 * HTB, NXCD = 8, WGM = 8;

__host__ __device__ __forceinline__ int lds_byte(int r, int c) { const int st = (r >> 4) * 2 + (c >> 5), rr = r & 15, cc = c & 31, ob = rr * 64 + cc * 2; return st * 1024 + (ob ^ (((ob >> 9) & 1) << 5)); }
__host__ __device__ __forceinline__ void stage_rc(int b, int& R, int& C) { const int st = b / 1024, sb = b % 1024, swz = sb ^ (((sb >> 9) & 1) << 5); R = (st >> 1) * 16 + swz / 64; C = (st & 1) * 32 + (swz % 64) / 2; }
__host__ __device__ __forceinline__ int perm32(int rho) { const int n = rho >> 4, i = rho & 15; return 8 * (i >> 2) + 4 * n + (i & 3); }

struct Unit { int pm, pn; long boff; int tb, tmax; };
struct Gemm { const bf16_t* A; const bf16_t* Bt; int M, N, K; const int* tok; };

struct StaticOrder {
    int nM, nN, nwg, G, c;
    __host__ __device__ void init(int M, int N, int G_, int c_) { nM = M / BM; nN = N / BM; nwg = nM * nN; G = G_; c = c_; }
    __host__ __device__ bool next(int i, Unit& u) const {
        const long L = (long)i * G + c; if (L >= nwg) return false;
        int wgid = (int)L; { const int q = nwg / NXCD, r = nwg % NXCD, xcd = wgid % NXCD, off = wgid / NXCD; wgid = (xcd < r ? xcd * (q + 1) : r * (q + 1) + (xcd - r) * q) + off; }
        const int nig = WGM * nN, gid = wgid / nig, fm = gid * WGM, gsz = (nM - fm) < WGM ? (nM - fm) : WGM;
        u.pm = fm + ((wgid % nig) % gsz); u.pn = (wgid % nig) / gsz; u.boff = 0; u.tb = 0; u.tmax = 0; return true;
    }
    __device__ __forceinline__ void a_ready(const Unit&) const {}
    __device__ __forceinline__ void done(const Unit&) const {}
};

__device__ __forceinline__ unsigned cvt_pk_bf16(float lo, float hi) { unsigned r; asm volatile("v_cvt_pk_bf16_f32 %0, %1, %2" : "=v"(r) : "v"(lo), "v"(hi)); return r; }
typedef float f32x2 __attribute__((ext_vector_type(2)));
__device__ __forceinline__ f32x2 gelu_pk(f32x2 v) {
    const f32x2 av = __builtin_elementwise_abs(v), d = av * 0.2316418882f + 1.0f;
    f32x2 t; t.x = __builtin_amdgcn_rcpf(d.x); t.y = __builtin_amdgcn_rcpf(d.y);
    f32x2 q = t * 0.5307027145f + (-0.7265760135f); q = q * t + 0.7107068705f; q = q * t + (-0.142248368f); q = q * t + 0.127414796f; q = q * t;
    const f32x2 s = (v * v) * (-0.72134752044f);
    f32x2 e; e.x = __builtin_amdgcn_exp2f(s.x); e.y = __builtin_amdgcn_exp2f(s.y);
    const f32x2 m = v * (q * e), r = v - m;
    f32x2 o; o.x = v.x < 0.f ? m.x : r.x; o.y = v.y < 0.f ? m.y : r.y; return o;
}

template <int ACT  > struct EpiBf16 {
    static constexpr bool PERM = true, AFTER_DRAIN = false; static_assert(ACT == 0 || ACT == 1, "EpiBf16: ACT is 0 (none) or 1 (gelu_pk)");
    bf16_t* O; int ldc; const float* bias; int split_cols; size_t split_stride; float scale0;
    __device__ __forceinline__ void operator()(const f32x4 (&acc)[2][2][4][2], const Unit& u, int wr, int wc, int fr, int fq) const {
        const int row0 = u.pm * BM + wr * 64 + fr; int colt = u.pn * BM; bf16_t* base = O;
        float sc = 1.f; if (split_cols) { const int t = colt / split_cols; base += (size_t)t * split_stride; colt -= t * split_cols; if (t == 0) sc = scale0; }
        const int col0 = colt + wc * 32 + 8 * fq, bcol0 = u.pn * BM + wc * 32 + 8 * fq;
        f32x4 bv[2][2];
#pragma unroll
        for (int bj = 0; bj < 2; ++bj)
#pragma unroll
            for (int n = 0; n < 2; ++n) bv[bj][n] = bias ? *(const f32x4*)(bias + bcol0 + bj * HALF + 4 * n) : (f32x4){0.f, 0.f, 0.f, 0.f};
#pragma unroll
        for (int ai = 0; ai < 2; ++ai)
#pragma unroll
            for (int m = 0; m < 4; ++m) { bf16_t* rowp = base + (size_t)(row0 + ai * HALF + m * 16) * ldc + col0;
#pragma unroll
                for (int bj = 0; bj < 2; ++bj) { f32x4 v0 = acc[ai][bj][m][0] + bv[bj][0], v1 = acc[ai][bj][m][1] + bv[bj][1];
                    if (ACT == 1) { f32x2 a = gelu_pk((f32x2){v0[0], v0[1]}), b = gelu_pk((f32x2){v0[2], v0[3]}), c = gelu_pk((f32x2){v1[0], v1[1]}), d = gelu_pk((f32x2){v1[2], v1[3]});
                        v0 = (f32x4){a.x, a.y, b.x, b.y}; v1 = (f32x4){c.x, c.y, d.x, d.y}; }
                    v0 = v0 * sc; v1 = v1 * sc; u32x4 w; w.x = cvt_pk_bf16(v0[0], v0[1]); w.y = cvt_pk_bf16(v0[2], v0[3]); w.z = cvt_pk_bf16(v1[0], v1[1]); w.w = cvt_pk_bf16(v1[2], v1[3]);
                    *(u32x4*)(rowp + bj * HALF) = w; } }
    }
};

template <class Epi, class Sched, bool ALIGN_EPI = false, bool SP2 = false, bool GATHER = false>
__device__ __forceinline__ void gemm_phase(PG8_LAS unsigned char* lds, const Gemm g, const Sched& S, const Epi& E, const int tid) {
    const int wid = __builtin_amdgcn_readfirstlane(tid >> 6), lane = tid & 63, wr = wid >> 2, wc = wid & 3, fr = lane & 15, fq = lane >> 4;
    const int K = g.K, nt = K / BK;
    unsigned voffA[2], voffB[2];
#pragma unroll
    for (int i = 0; i < 2; ++i) { int R, C; stage_rc(tid * 16 + i * 8192, R, C); const int Rb = Epi::PERM ? ((R & ~31) + perm32(R & 31)) : R;
        voffA[i] = (unsigned)(R * K + C) * 2u; voffB[i] = (unsigned)(Rb * K + C) * 2u; }
    const size_t kstep = (size_t)(BK * 2);
    const size_t hstep = (size_t)HALF * K * 2;
    const size_t tstep = 2 * hstep;
    const unsigned ldsw = (unsigned)wid * 1024u;
    const int aoff = lds_byte(wr * 64 + fr, fq * 8), boff = lds_byte(wc * 32 + fr, fq * 8);
#define PG8_SA(b, h) (((b) * 2 + (h)) * HTB)
#define PG8_SB(b, h) ((4 + (b) * 2 + (h)) * HTB)
#define PG8_STAGE(bufoff, gbase, voff) do { _Pragma("unroll") for (int _i = 0; _i < 2; ++_i) \
        __builtin_amdgcn_global_load_lds((const unsigned*)((const char*)(gbase) + (voff)[_i]), (PG8_LAS unsigned*)(lds + (bufoff) + ldsw + _i * 8192), 16, 0, 0); } while (0)
    static_assert(!GATHER || SP2, "gather is wired into the SP2 loop only");
    unsigned gc00 = 0u, gc01 = 0u, gc10 = 0u, gc11 = 0u, gn00 = 0u, gn01 = 0u, gn10 = 0u, gn11 = 0u;
#define PG8_GOFF(u_, o00, o01, o10, o11) do { int R0_, C0_, R1_, C1_; stage_rc(tid * 16, R0_, C0_); stage_rc(tid * 16 + 8192, R1_, C1_); const int tb_ = (u_).tb, tm_ = (u_).tmax; \
        o00 = (unsigned)(g.tok[min(tb_ + R0_, tm_)] * K + C0_) * 2u; o01 = (unsigned)(g.tok[min(tb_ + R1_, tm_)] * K + C1_) * 2u; \
        o10 = (unsigned)(g.tok[min(tb_ + HALF + R0_, tm_)] * K + C0_) * 2u; o11 = (unsigned)(g.tok[min(tb_ + HALF + R1_, tm_)] * K + C1_) * 2u; } while (0)
#define PG8_STAGE2(bufoff, gbase, v0_, v1_) do { \
        __builtin_amdgcn_global_load_lds((const unsigned*)((const char*)(gbase) + (v0_)), (PG8_LAS unsigned*)(lds + (bufoff) + ldsw), 16, 0, 0); \
        __builtin_amdgcn_global_load_lds((const unsigned*)((const char*)(gbase) + (v1_)), (PG8_LAS unsigned*)(lds + (bufoff) + ldsw + 8192), 16, 0, 0); } while (0)
#define PG8_STAGE_A(bufoff, dense_ptr, kb_, h_, nx_) do { if constexpr (GATHER) { const char* gb_ = (const char*)g.A + (kb_); \
            if ((h_) == 0) PG8_STAGE2(bufoff, gb_, (nx_) ? gn00 : gc00, (nx_) ? gn01 : gc01); else PG8_STAGE2(bufoff, gb_, (nx_) ? gn10 : gc10, (nx_) ? gn11 : gc11); } \
        else PG8_STAGE(bufoff, dense_ptr, voffA); } while (0)
#define PG8_LDA(dst, b, h) do { _Pragma("unroll") for (int m = 0; m < 4; ++m) _Pragma("unroll") for (int k = 0; k < 2; ++k) dst[m][k] = *(const PG8_LAS bf16x8*)(lds + PG8_SA(b, h) + aoff + m * 2048 + k * 1024); } while (0)
#define PG8_LDB(dst, b, h) do { _Pragma("unroll") for (int n = 0; n < 2; ++n) _Pragma("unroll") for (int k = 0; k < 2; ++k) dst[n][k] = *(const PG8_LAS bf16x8*)(lds + PG8_SB(b, h) + boff + n * 2048 + k * 1024); } while (0)
#define PG8_MMA(ai, bj, At, Bt) do { __builtin_amdgcn_s_setprio(1); _Pragma("unroll") for (int m = 0; m < 4; ++m) _Pragma("unroll") for (int n = 0; n < 2; ++n) _Pragma("unroll") for (int k = 0; k < 2; ++k) \
        acc[ai][bj][m][n] = __builtin_amdgcn_mfma_f32_16x16x32_bf16(Bt[n][k], At[m][k], acc[ai][bj][m][n], 0, 0, 0); __builtin_amdgcn_s_setprio(0); } while (0)
#define PG8_WAIT_V(n) asm volatile("s_waitcnt vmcnt(" #n ")" ::: "memory")
#define PG8_WAIT_L(n) asm volatile("s_waitcnt lgkmcnt(" #n ")" ::: "memory")
#define PG8_BAR __builtin_amdgcn_s_barrier()
#define PG8_SCHED __builtin_amdgcn_sched_barrier(0)
    Unit cur, nxt; int ui = 0;
    if (!S.next(0, cur)) return;
    f32x4 acc[2][2][4][2];
#pragma unroll
    for (int a = 0; a < 2; ++a)
#pragma unroll
        for (int b = 0; b < 2; ++b)
#pragma unroll
            for (int m = 0; m < 4; ++m)
#pragma unroll
                for (int n = 0; n < 2; ++n) acc[a][b][m][n] = (f32x4){0.f, 0.f, 0.f, 0.f};
    bf16x8 At[4][2], B0[2][2], B1[2][2];
    const char* cA = (const char*)g.A + (size_t)cur.pm * tstep; const char* cB = (const char*)g.Bt + cur.boff + (size_t)cur.pn * tstep;
    S.a_ready(cur);
    if constexpr (GATHER) PG8_GOFF(cur, gc00, gc01, gc10, gc11);
    if constexpr (SP2) {
        PG8_STAGE(PG8_SB(0, 0), cB, voffB); PG8_STAGE(PG8_SB(0, 1), cB + hstep, voffB); PG8_STAGE_A(PG8_SA(0, 0), cA, (size_t)0, 0, false); PG8_STAGE_A(PG8_SA(0, 1), cA + hstep, (size_t)0, 1, false);
        if (wr == 1) PG8_BAR;
        PG8_WAIT_V(2); PG8_BAR;
        PG8_STAGE(PG8_SB(1, 0), cB + kstep, voffB); PG8_STAGE_A(PG8_SA(1, 0), cA + kstep, kstep, 0, false); PG8_STAGE(PG8_SB(1, 1), cB + hstep + kstep, voffB);
        PG8_WAIT_V(6); PG8_BAR;
    } else {
        PG8_STAGE(PG8_SB(0, 0), cB, voffB); PG8_STAGE(PG8_SA(0, 0), cA, voffA); PG8_STAGE(PG8_SB(0, 1), cB + hstep, voffB); PG8_STAGE(PG8_SA(0, 1), cA + hstep, voffA);
        if (wr == 1) PG8_BAR;
        PG8_WAIT_V(4); PG8_BAR;
        PG8_STAGE(PG8_SB(1, 0), cB + kstep, voffB); PG8_STAGE(PG8_SA(1, 0), cA + kstep, voffA); PG8_STAGE(PG8_SB(1, 1), cB + hstep + kstep, voffB);
        PG8_WAIT_V(6); PG8_BAR;
    }
    for (;;) {
        const bool has_next = S.next(ui + 1, nxt);
        if constexpr (GATHER) { if (has_next) PG8_GOFF(nxt, gn00, gn01, gn10, gn11); else { gn00 = gc00; gn01 = gc01; gn10 = gc10; gn11 = gc11; } }
        const char* nA = has_next ? (const char*)g.A + (size_t)nxt.pm * tstep : cA; const char* nB = has_next ? (const char*)g.Bt + nxt.boff + (size_t)nxt.pn * tstep : cB;
        for (int t = 0; t < nt; t += 2) {
            const bool last = (t == nt - 2);
            const char* a1 = cA + (size_t)(t + 1) * kstep;
            const char* a2 = last ? nA : cA + (size_t)(t + 2) * kstep; const char* b2 = last ? nB : cB + (size_t)(t + 2) * kstep;
            const char* a3 = a2 + kstep; const char* b3 = b2 + kstep;
            const size_t k1 = (size_t)(t + 1) * kstep, k2 = last ? (size_t)0 : (size_t)(t + 2) * kstep, k3 = k2 + kstep;
            if (last && has_next) S.a_ready(nxt);
            if constexpr (SP2) {
            PG8_LDB(B0, 0, 0); PG8_LDB(B1, 0, 1); PG8_SCHED; PG8_LDA(At, 0, 0); PG8_STAGE_A(PG8_SA(1, 1), a1 + hstep, k1, 1, false);
            PG8_WAIT_V(8); PG8_WAIT_L(0); PG8_BAR; PG8_MMA(0, 0, At, B0); PG8_MMA(0, 1, At, B1); PG8_BAR; PG8_SCHED;
            PG8_LDA(At, 0, 1); PG8_STAGE(PG8_SB(0, 0), b2, voffB); PG8_STAGE(PG8_SB(0, 1), b2 + hstep, voffB); PG8_STAGE_A(PG8_SA(0, 0), a2, k2, 0, last);
            PG8_WAIT_V(8); PG8_WAIT_L(0); PG8_BAR; PG8_MMA(1, 0, At, B0); PG8_MMA(1, 1, At, B1); PG8_BAR; PG8_SCHED;
            PG8_LDB(B0, 1, 0); PG8_LDB(B1, 1, 1); PG8_SCHED; PG8_LDA(At, 1, 0); PG8_STAGE_A(PG8_SA(0, 1), a2 + hstep, k2, 1, last);
            PG8_WAIT_V(8); PG8_WAIT_L(0); PG8_BAR; PG8_MMA(0, 0, At, B0); PG8_MMA(0, 1, At, B1); PG8_BAR; PG8_SCHED;
            PG8_LDA(At, 1, 1); PG8_STAGE(PG8_SB(1, 0), b3, voffB); PG8_STAGE(PG8_SB(1, 1), b3 + hstep, voffB); PG8_STAGE_A(PG8_SA(1, 0), a3, k3, 0, last);
            PG8_WAIT_V(8); PG8_WAIT_L(0); PG8_BAR; PG8_MMA(1, 0, At, B0); PG8_MMA(1, 1, At, B1); PG8_BAR; PG8_SCHED;
            } else {
            PG8_LDB(B0, 0, 0); PG8_SCHED; PG8_LDA(At, 0, 0); PG8_STAGE(PG8_SA(1, 1), a1 + hstep, voffA);
            PG8_WAIT_L(8); PG8_BAR; PG8_WAIT_L(0); PG8_MMA(0, 0, At, B0); PG8_BAR; PG8_SCHED;
            PG8_LDB(B1, 0, 1); PG8_STAGE(PG8_SB(0, 0), b2, voffB);
            PG8_BAR; PG8_WAIT_L(0); PG8_MMA(0, 1, At, B1); PG8_BAR;
            PG8_LDA(At, 0, 1); PG8_STAGE(PG8_SA(0, 0), a2, voffA);
            PG8_BAR; PG8_WAIT_L(0); PG8_MMA(1, 0, At, B0); PG8_BAR; PG8_SCHED;
            PG8_STAGE(PG8_SB(0, 1), b2 + hstep, voffB);
            PG8_WAIT_V(6); PG8_BAR; PG8_MMA(1, 1, At, B1); PG8_BAR;
            PG8_LDB(B0, 1, 0); PG8_SCHED; PG8_LDA(At, 1, 0); PG8_STAGE(PG8_SA(0, 1), a2 + hstep, voffA);
            PG8_WAIT_L(8); PG8_BAR; PG8_WAIT_L(0); PG8_MMA(0, 0, At, B0); PG8_BAR; PG8_SCHED;
            PG8_LDB(B1, 1, 1); PG8_STAGE(PG8_SB(1, 0), b3, voffB);
            PG8_BAR; PG8_WAIT_L(0); PG8_MMA(0, 1, At, B1); PG8_BAR;
            PG8_LDA(At, 1, 1); PG8_STAGE(PG8_SA(1, 0), a3, voffA);
            PG8_BAR; PG8_WAIT_L(0); PG8_MMA(1, 0, At, B0); PG8_BAR; PG8_SCHED;
            PG8_STAGE(PG8_SB(1, 1), b3 + hstep, voffB);
            PG8_WAIT_V(6); PG8_BAR; PG8_MMA(1, 1, At, B1); PG8_BAR;
            }
        }
        if constexpr (ALIGN_EPI) { if (wr == 0) PG8_BAR; }
        if constexpr (!Epi::AFTER_DRAIN) { E(acc, cur, wr, wc, fr, fq); S.done(cur); }
        if (!has_next) break;
#pragma unroll
        for (int a = 0; a < 2; ++a)
#pragma unroll
            for (int b = 0; b < 2; ++b)
#pragma unroll
                for (int m = 0; m < 4; ++m)
#pragma unroll
                    for (int n = 0; n < 2; ++n) acc[a][b][m][n] = (f32x4){0.f, 0.f, 0.f, 0.f};
        cur = nxt; cA = nA; cB = nB; ++ui; gc00 = gn00; gc01 = gn01; gc10 = gn10; gc11 = gn11;
        if constexpr (ALIGN_EPI) { if (wr == 1) PG8_BAR; }
    }
    PG8_WAIT_V(0);
    if constexpr (!ALIGN_EPI) { if (wr == 0) PG8_BAR; }
    PG8_BAR;
    if constexpr (Epi::AFTER_DRAIN) { E.fused(acc, cur, wr, wc, fr, fq, lds, wid, lane); S.done(cur); }
#undef PG8_SA
#undef PG8_SB
#undef PG8_STAGE
#undef PG8_STAGE2
#undef PG8_STAGE_A
#undef PG8_GOFF
#undef PG8_LDA
#undef PG8_LDB
#undef PG8_MMA
#undef PG8_WAIT_V
#undef PG8_WAIT_L
#undef PG8_BAR
#undef PG8_SCHED
}
}

namespace {
typedef unsigned short bf16_t;
typedef float f32x4 __attribute__((ext_vector_type(4)));
typedef unsigned u32x4 __attribute__((ext_vector_type(4)));
typedef unsigned u32x2 __attribute__((ext_vector_type(2)));
#define LAS __attribute__((address_space(3)))

constexpr int T = 32768, L = 8192, NB = 4, D = 1024, DIN = 2616, PL = 2816;
constexpr int OQ = 0, OKK = 192, OV = 384, OLR = 768, ORR = 784, DQ = 1168, DK = 1424, DV = 1680, IQ = 1936, IK = 2192, IW = 2224, SU = 2232;
constexpr int NE = 32, MAXTILES = 288, NWAVES = 8;

constexpr size_t OFF_CTL = 0;
constexpr size_t OFF_MOD = 64 * 1024;
constexpr size_t OFF_CNT = 320 * 1024;
constexpr size_t OFF_EID = 384 * 1024;
constexpr size_t OFF_EW = OFF_EID + (size_t)T * 8;
constexpr size_t OFF_SLOT = OFF_EW + (size_t)T * 8;
constexpr size_t OFF_POS = OFF_SLOT + (size_t)T * 8;
constexpr size_t OFF_TOK = OFF_POS + (size_t)T * 8;
constexpr size_t OFF_W = 2 * 1024 * 1024;
constexpr size_t W_WIN = 0;
constexpr size_t W_WOUT = W_WIN + (size_t)2 * PL * D * 2;
constexpr size_t W_GLU = W_WOUT + (size_t)2 * D * D * 2;
constexpr size_t W_EGU = W_GLU + (size_t)2 * 384 * 384 * 2;
constexpr size_t W_EDN = W_EGU + (size_t)NE * 1024 * 1024 * 2;
constexpr size_t W_BYTES = W_EDN + (size_t)NE * 1024 * 512 * 2;
constexpr size_t OFF_HN = OFF_W + W_BYTES;
constexpr size_t OFF_C = OFF_HN + (size_t)T * D * 2;
constexpr size_t C_BYTES = (size_t)T * PL * 2;
constexpr size_t OFF_D = OFF_C + C_BYTES;
constexpr size_t D_BYTES = (size_t)MAXTILES * 256 * 1024 * 2;
constexpr size_t D_Y = (size_t)T * D * 2;
constexpr size_t OFF_E = OFF_D + D_BYTES;
constexpr size_t E_UPD = 0;
constexpr size_t E_DEC = E_UPD + (size_t)2048 * 4608 * 4;
constexpr size_t E_MASK = E_DEC + (size_t)2048 * 48 * 4;
constexpr size_t E_S5E = E_MASK + (size_t)T * 128 * 8;
constexpr size_t E_IKC = E_S5E + (size_t)4 * 24 * 128 * 64 * 2 * 4;
constexpr size_t E_BYTES = 78643200 + 2097152;
static_assert(E_IKC + (size_t)T * 32 * 2 <= E_BYTES, "E scratch overflow");
static_assert((size_t)MAXTILES * 256 * 512 * 2 <= E_BYTES, "HID overflow");
static_assert((size_t)MAXTILES * 256 * 1024 * 2 <= C_BYTES, "ROWS overflow");
static_assert(D_Y + (size_t)T * 384 * 4 <= D_BYTES, "Y overflow");
constexpr size_t WS_NEED = OFF_E + E_BYTES;

__device__ __forceinline__ float bf2f(bf16_t v) { return __uint_as_float((unsigned)v << 16); }
__device__ __forceinline__ unsigned pk2(float lo, float hi) { unsigned r; asm("v_cvt_pk_bf16_f32 %0, %1, %2" : "=v"(r) : "v"(lo), "v"(hi)); return r; }
__device__ __forceinline__ unsigned f2bf(float f) { return pk2(f, 0.f) & 0xffffu; }
__device__ __forceinline__ float4 ld4bf(const bf16_t* p) { const u32x2 w = *(const u32x2*)p; return make_float4(__uint_as_float(w.x << 16), __uint_as_float(w.x & 0xffff0000u), __uint_as_float(w.y << 16), __uint_as_float(w.y & 0xffff0000u)); }
__device__ __forceinline__ float fsigmoid(float v) { return __builtin_amdgcn_rcpf(1.f + __builtin_amdgcn_exp2f(-1.4426950408889634f * v)); }
__device__ __forceinline__ float siluf(float v) { return v * fsigmoid(v); }
__device__ __forceinline__ float shx(float v, int m, int lane) { return __int_as_float(__builtin_amdgcn_ds_bpermute((lane ^ m) << 2, __float_as_int(v))); }
__device__ __forceinline__ unsigned shxu(unsigned v, int m, int lane) { return (unsigned)__builtin_amdgcn_ds_bpermute((lane ^ m) << 2, (int)v); }
__device__ __forceinline__ unsigned shdnu(unsigned v, int d, int lane) { return (unsigned)__builtin_amdgcn_ds_bpermute((lane + d) << 2, (int)v); }
__device__ __forceinline__ int shupi(int v, int d, int lane) { return __builtin_amdgcn_ds_bpermute((lane - d) << 2, v); }
__device__ __forceinline__ unsigned shidxu(unsigned v, int src) { return (unsigned)__builtin_amdgcn_ds_bpermute(src << 2, (int)v); }
#define DPP_F(v_, ctrl_) __int_as_float(__builtin_amdgcn_update_dpp(0, __float_as_int(v_), (ctrl_), 0xf, 0xf, true))
__device__ __forceinline__ float wave_sum(float v, int lane) {
    (void)lane;
    v += DPP_F(v, 0xB1); v += DPP_F(v, 0x4E); v += DPP_F(v, 0x141); v += DPP_F(v, 0x140);
    { const auto s_ = __builtin_amdgcn_permlane16_swap(__float_as_uint(v), __float_as_uint(v), false, false); v = __uint_as_float(s_[0]) + __uint_as_float(s_[1]); }
    { const auto s_ = __builtin_amdgcn_permlane32_swap(__float_as_uint(v), __float_as_uint(v), false, false); v = __uint_as_float(s_[0]) + __uint_as_float(s_[1]); }
    return v;
}
__device__ __forceinline__ float wave_max(float v, int lane) {
    (void)lane;
    v = fmaxf(v, DPP_F(v, 0xB1)); v = fmaxf(v, DPP_F(v, 0x4E)); v = fmaxf(v, DPP_F(v, 0x141)); v = fmaxf(v, DPP_F(v, 0x140));
    { const auto s_ = __builtin_amdgcn_permlane16_swap(__float_as_uint(v), __float_as_uint(v), false, false); v = fmaxf(__uint_as_float(s_[0]), __uint_as_float(s_[1])); }
    { const auto s_ = __builtin_amdgcn_permlane32_swap(__float_as_uint(v), __float_as_uint(v), false, false); v = fmaxf(__uint_as_float(s_[0]), __uint_as_float(s_[1])); }
    return v;
}
#define DPP_U(v_, ctrl_) ((unsigned)__builtin_amdgcn_update_dpp(0, (int)(v_), (ctrl_), 0xf, 0xf, true))
__device__ __forceinline__ float row_sum16(float v) { v += DPP_F(v, 0xB1); v += DPP_F(v, 0x4E); v += DPP_F(v, 0x141); v += DPP_F(v, 0x140); return v; }
__device__ __forceinline__ unsigned half_sum32u(unsigned v) { v += DPP_U(v, 0xB1); v += DPP_U(v, 0x4E); v += DPP_U(v, 0x141); v += DPP_U(v, 0x140);
    const auto s_ = __builtin_amdgcn_permlane16_swap(v, v, false, false); return s_[0] + s_[1]; }
__device__ __forceinline__ unsigned wave_incl_scan_u(unsigned v) {
    v += DPP_U(v, 0x111); v += DPP_U(v, 0x112); v += DPP_U(v, 0x114); v += DPP_U(v, 0x118);
    v += (unsigned)__builtin_amdgcn_update_dpp(0, (int)v, 0x142, 0xa, 0xf, false);
    v += (unsigned)__builtin_amdgcn_update_dpp(0, (int)v, 0x143, 0xc, 0xf, false);
    return v;
}
__device__ __forceinline__ float wave_incl_scan_f(float v) {
    v += DPP_F(v, 0x111); v += DPP_F(v, 0x112); v += DPP_F(v, 0x114); v += DPP_F(v, 0x118);
    v += __int_as_float(__builtin_amdgcn_update_dpp(0, __float_as_int(v), 0x142, 0xa, 0xf, false));
    v += __int_as_float(__builtin_amdgcn_update_dpp(0, __float_as_int(v), 0x143, 0xc, 0xf, false));
    return v;
}
__device__ __forceinline__ unsigned rdlane_u(unsigned v, int src) { return (unsigned)__builtin_amdgcn_readlane((int)v, src); }
__device__ __forceinline__ float sum_x32(float v) { const auto s_ = __builtin_amdgcn_permlane32_swap(__float_as_uint(v), __float_as_uint(v), false, false); return __uint_as_float(s_[0]) + __uint_as_float(s_[1]); }

__device__ __forceinline__ void transpose_item(const float* __restrict__ W, int ldw, int nvalid, bf16_t* __restrict__ WT, int ldt, int dst_row0, int k0, int n0, LAS float* scr, int lane) {
    const int n = n0 + (lane & 31); const bool ok = n < nvalid;
#pragma unroll 8
    for (int i = 0; i < 32; ++i) { const int kk = 2 * i + (lane >> 5); scr[kk * 33 + (lane & 31)] = ok ? __builtin_nontemporal_load(W + (size_t)(k0 + kk) * ldw + n) : 0.f; }
    asm volatile("s_waitcnt lgkmcnt(0)" ::: "memory");
    const int c = lane & 7;
#pragma unroll
    for (int j = 0; j < 4; ++j) { const int nl = (lane >> 3) + 8 * j; const LAS float* s = scr + (8 * c) * 33 + nl;
        u32x4 o; o.x = pk2(s[0 * 33], s[1 * 33]); o.y = pk2(s[2 * 33], s[3 * 33]); o.z = pk2(s[4 * 33], s[5 * 33]); o.w = pk2(s[6 * 33], s[7 * 33]);
        *(u32x4*)(WT + (size_t)(dst_row0 + nl) * ldt + k0 + 8 * c) = o; }
    asm volatile("s_waitcnt lgkmcnt(0)" ::: "memory");
}
__device__ __forceinline__ void convert_experts(const float* __restrict__ wgate, const float* __restrict__ wup, const float* __restrict__ wdown, bf16_t* EGU, bf16_t* EDN, LAS float* scr, int gw, int ngw, int lane) {
    for (int it = gw; it < 3 * 8192; it += ngw) {
        const int which = it >> 13, r = it & 8191, e = r >> 8, q = r & 255;
        if (which < 2) { const int kb = q >> 4, nb = q & 15, n0 = nb * 32; const float* W = (which == 0 ? wgate : wup) + (size_t)e * 1024 * 512;
            transpose_item(W, 512, 512, EGU + (size_t)e * 1024 * 1024, 1024, 256 * (n0 >> 7) + (n0 & 127) + 128 * which, kb * 64, n0, scr, lane); }
        else { const int kb = q >> 5, nb = q & 31; transpose_item(wdown + (size_t)e * 512 * 1024, 1024, 1024, EDN + (size_t)e * 1024 * 512, 512, nb * 32, kb * 64, nb * 32, scr, lane); }
    }
}
struct ProArgs { const float *c, *ada_w, *ada_b, *w_in, *w_out, *glu_w, *wgate, *wup, *wdown, *s5are, *s5aim, *s5lst; unsigned char* ws; int do_small, pad; };
__device__ __forceinline__ void ph_prologue(const ProArgs& a, LAS unsigned char* lds, const int tid, const int bx, const int G) {
    const int lane = tid & 63, wave = tid >> 6;
    const int gw = bx * NWAVES + wave, ngw = G * NWAVES;
    LAS float* scr = (LAS float*)(lds + wave * 8704);
    bf16_t* Wb = (bf16_t*)(a.ws + OFF_W);
    if (a.do_small) {
        for (int i = bx * 512 + tid; i < 2 * 1536; i += G * 512) {
            const int l = i / 1536, gp = i - 1536 * l, g = gp >> 6;
            const float dt = expf(a.s5lst[l * 24 + g]); const float ar = a.s5are[i], ai = a.s5aim[i];
            const float mag = expf(ar * dt); const float lr = mag * cosf(ai * dt), li = mag * sinf(ai * dt);
            const float den = ar * ar + ai * ai, nr = lr - 1.f, ni = li;
            ((float4*)(a.ws + OFF_TOK))[i] = make_float4(lr, li, (nr * ar + ni * ai) / den, (ni * ar - nr * ai) / den);
        }
        for (int u = bx; u < 256; u += G) {
            LAS float* sc = (LAS float*)(lds + 70 * 1024);
            LAS float* red = sc + 4096;
            __syncthreads();
            for (int i = tid; i < 4096; i += 512) sc[i] = siluf(a.c[i]);
            __syncthreads();
            const int col0 = u * 48, l = col0 / 6144, j0 = col0 % 6144;
            if (tid < 480) {
                const int ks = tid / 48, col = tid % 48;
                const float* w = a.ada_w + (size_t)l * 1024 * 6144 + j0 + col;
                float a0 = 0.f, a1 = 0.f, a2 = 0.f, a3 = 0.f;
#pragma unroll 8
                for (int k = ks; k < 1024; k += 10) { const float wv = w[(size_t)k * 6144]; a0 += sc[k] * wv; a1 += sc[1024 + k] * wv; a2 += sc[2048 + k] * wv; a3 += sc[3072 + k] * wv; }
                red[(ks * 48 + col) * 4 + 0] = a0; red[(ks * 48 + col) * 4 + 1] = a1; red[(ks * 48 + col) * 4 + 2] = a2; red[(ks * 48 + col) * 4 + 3] = a3;
            }
            __syncthreads();
            if (tid < 192) { const int b = tid / 48, col = tid % 48; float s = a.ada_b[l * 6144 + j0 + col];
                for (int ks = 0; ks < 10; ++ks) s += red[(ks * 48 + col) * 4 + b];
                ((float*)(a.ws + OFF_MOD))[(l * 4 + b) * 6144 + j0 + col] = s; }
        }
        __syncthreads();
        constexpr int I_IN = 16 * 88, I_OUT = 16 * 32, I_GLU = 6 * 12, I_ALL = 2 * (I_IN + I_OUT + I_GLU);
        for (int it = gw; it < I_ALL; it += ngw) {
            int r = it; const int l = r / (I_IN + I_OUT + I_GLU); r -= l * (I_IN + I_OUT + I_GLU);
            if (r < I_IN) { const int kb = r / 88, nb = r % 88; transpose_item(a.w_in + (size_t)l * D * DIN, DIN, DIN, (bf16_t*)((unsigned char*)Wb + W_WIN) + (size_t)l * PL * D, D, nb * 32, kb * 64, nb * 32, scr, lane); continue; }
            r -= I_IN;
            if (r < I_OUT) { const int kb = r / 32, nb = r % 32; transpose_item(a.w_out + (size_t)l * D * D, D, D, (bf16_t*)((unsigned char*)Wb + W_WOUT) + (size_t)l * D * D, D, nb * 32, kb * 64, nb * 32, scr, lane); continue; }
            r -= I_OUT;
            { const int kb = r / 12, nb = r % 12; transpose_item(a.glu_w + (size_t)l * 384 * 384, 384, 384, (bf16_t*)((unsigned char*)Wb + W_GLU) + (size_t)l * 384 * 384, 384, nb * 32, kb * 64, nb * 32, scr, lane); }
        }
    }
    convert_experts(a.wgate, a.wup, a.wdown, (bf16_t*)((unsigned char*)Wb + W_EGU), (bf16_t*)((unsigned char*)Wb + W_EDN), scr, gw, ngw, lane);
}

struct EpiRes {
    static constexpr bool PERM = false, AFTER_DRAIN = false;
    const float* xin; float* xout; const float* gt;
    __device__ __forceinline__ void operator()(const pg8::f32x4 (&acc)[2][2][4][2], const pg8::Unit& u, int wr, int wc, int fr, int fq) const {
        const int row0 = u.pm * 256 + wr * 64 + fr, col0 = u.pn * 256 + wc * 32 + 4 * fq;
#pragma unroll
        for (int ai = 0; ai < 2; ++ai)
#pragma unroll
            for (int m = 0; m < 4; ++m) { const int row = row0 + ai * 128 + m * 16; const float* gr = gt + (row >> 13) * 6144; const size_t ro = (size_t)row * D;
#pragma unroll
                for (int bj = 0; bj < 2; ++bj)
#pragma unroll
                    for (int n = 0; n < 2; ++n) { const int col = col0 + bj * 128 + n * 16;
                        const pg8::f32x4 g4 = *(const pg8::f32x4*)(gr + col), xi = *(const pg8::f32x4*)(xin + ro + col);
                        *(pg8::f32x4*)(xout + ro + col) = xi + g4 * acc[ai][bj][m][n]; } }
    }
};
struct EpiProj {
    static constexpr bool PERM = true, AFTER_DRAIN = false;
    bf16_t* O; bf16_t* IKC;
    __device__ __forceinline__ void operator()(const pg8::f32x4 (&acc)[2][2][4][2], const pg8::Unit& u, int wr, int wc, int fr, int fq) const {
        const int row0 = u.pm * 256 + wr * 64 + fr, col0 = u.pn * 256 + wc * 32 + 8 * fq;
#pragma unroll
        for (int ai = 0; ai < 2; ++ai)
#pragma unroll
            for (int m = 0; m < 4; ++m) { const int row = row0 + ai * 128 + m * 16; bf16_t* rowp = O + (size_t)row * PL + col0;
#pragma unroll
                for (int bj = 0; bj < 2; ++bj) { const pg8::f32x4 v0 = acc[ai][bj][m][0], v1 = acc[ai][bj][m][1];
                    u32x4 w; w.x = pg8::cvt_pk_bf16(v0[0], v0[1]); w.y = pg8::cvt_pk_bf16(v0[2], v0[3]); w.z = pg8::cvt_pk_bf16(v1[0], v1[1]); w.w = pg8::cvt_pk_bf16(v1[2], v1[3]);
                    *(u32x4*)(rowp + bj * 128) = w;
                    const int col = col0 + bj * 128;
                    if (col >= IK && col < IK + 32) *(u32x4*)(IKC + (size_t)row * 32 + (col - IK)) = w; } }
    }
};
struct EpiGU {
    static constexpr bool PERM = true, AFTER_DRAIN = false;
    bf16_t* HID;
    __device__ __forceinline__ void operator()(const pg8::f32x4 (&acc)[2][2][4][2], const pg8::Unit& u, int wr, int wc, int fr, int fq) const {
        const int row0 = u.pm * 256 + wr * 64 + fr, col0 = u.pn * 128 + wc * 32 + 8 * fq;
#pragma unroll
        for (int ai = 0; ai < 2; ++ai)
#pragma unroll
            for (int m = 0; m < 4; ++m) { bf16_t* rowp = HID + (size_t)(row0 + ai * 128 + m * 16) * 512 + col0;
                const pg8::f32x4 g0 = acc[ai][0][m][0], g1 = acc[ai][0][m][1], u0 = acc[ai][1][m][0], u1 = acc[ai][1][m][1];
                u32x4 w; w.x = pg8::cvt_pk_bf16(siluf(g0[0]) * u0[0], siluf(g0[1]) * u0[1]); w.y = pg8::cvt_pk_bf16(siluf(g0[2]) * u0[2], siluf(g0[3]) * u0[3]);
                w.z = pg8::cvt_pk_bf16(siluf(g1[0]) * u1[0], siluf(g1[1]) * u1[1]); w.w = pg8::cvt_pk_bf16(siluf(g1[2]) * u1[2], siluf(g1[3]) * u1[3]);
                *(u32x4*)rowp = w; }
    }
};
constexpr int MOE_PLAN = 140 * 1024;
__device__ __forceinline__ void moe_plan(LAS unsigned* pl, const unsigned* __restrict__ cnt, const int tid) {
    __syncthreads();
    if (tid < 64) {
        const unsigned c = tid < NE ? __builtin_nontemporal_load(cnt + 64 * (tid & (NE - 1))) : 0u, nt = (c + 255u) / 256u;
        const unsigned inc = wave_incl_scan_u(nt);
        if (tid < NE) { pl[40 + tid] = c; pl[tid] = inc - nt; }
        if (tid == NE - 1) { pl[NE] = inc; pl[72] = inc; }
    }
    __syncthreads();
    if (tid < 288) { unsigned e = 0;
#pragma unroll
        for (int k = 1; k < NE; ++k) e += (pl[k] <= (unsigned)tid) ? 1u : 0u;
        pl[128 + tid] = e; }
    __syncthreads();
}
struct MoeOrder {
    const LAS unsigned* plan; int nN; long estride; int G, c;
    __device__ __forceinline__ void init(int G_, int c_) { G = G_; c = (c_ % 8) * (G_ / 8) + c_ / 8; }
    __device__ __forceinline__ bool next(int i, pg8::Unit& u) const {
        const int ntiles = __builtin_amdgcn_readfirstlane((int)plan[72]); const long Lx = (long)i * G + c; if (Lx >= (long)ntiles * nN) return false;
        u.pm = (int)(Lx / nN); u.pn = (int)(Lx % nN);
        const int e = __builtin_amdgcn_readfirstlane((int)plan[128 + u.pm]), ts = __builtin_amdgcn_readfirstlane((int)plan[e]), cn = __builtin_amdgcn_readfirstlane((int)plan[40 + e]);
        u.boff = (long)e * estride; u.tb = e * 65536 + (u.pm - ts) * 256; u.tmax = e * 65536 + cn - 1; return true;
    }
    __device__ __forceinline__ void a_ready(const pg8::Unit&) const {}
    __device__ __forceinline__ void done(const pg8::Unit&) const {}
};

typedef short bf16x8_t __attribute__((ext_vector_type(8)));
typedef float f32x16_t __attribute__((ext_vector_type(16)));
typedef short s16x4_t __attribute__((ext_vector_type(4)));
struct Params { const float* in[31]; float* out; unsigned char* ws; };

__device__ __forceinline__ void ph_norm1(const float* xin, const float* __restrict__ g, const float* __restrict__ modl, bf16_t* __restrict__ out, const int tid, const int bx, const int G) {
    const int wave = tid >> 6, lane = tid & 63;
    for (int row = bx * NWAVES + wave; row < T; row += G * NWAVES) {
        const int b = row / L; const float* xr = xin + (size_t)row * D;
        f32x4 v[4]; float ss = 0.f;
#pragma unroll
        for (int i = 0; i < 4; ++i) { v[i] = *(const f32x4*)(xr + 4 * lane + 256 * i); ss += v[i].x * v[i].x + v[i].y * v[i].y + v[i].z * v[i].z + v[i].w * v[i].w; }
        ss = wave_sum(ss, lane);
        const float r = rsqrtf(ss * (1.f / D) + 1e-6f);
#pragma unroll
        for (int i = 0; i < 4; ++i) {
            const int col = 4 * lane + 256 * i;
            const f32x4 gg = *(const f32x4*)(g + col), sc = *(const f32x4*)(modl + b * 6144 + 1024 + col), sh = *(const f32x4*)(modl + b * 6144 + col);
            const f32x4 y = v[i] * r * gg * (sc + 1.f) + sh;
            u32x2 o; o.x = pk2(y.x, y.y); o.y = pk2(y.z, y.w);
            *(u32x2*)(out + (size_t)row * D + col) = o;
        }
    }
}
__device__ __forceinline__ void ph_final_norm(float* X, const float* __restrict__ g, const int tid, const int bx, const int G) {
    const int wave = tid >> 6, lane = tid & 63;
    for (int row = bx * NWAVES + wave; row < T; row += G * NWAVES) {
        float* xr = X + (size_t)row * D;
        f32x4 v[4]; float ss = 0.f;
#pragma unroll
        for (int i = 0; i < 4; ++i) { v[i] = *(const f32x4*)(xr + 4 * lane + 256 * i); ss += v[i].x * v[i].x + v[i].y * v[i].y + v[i].z * v[i].z + v[i].w * v[i].w; }
        ss = wave_sum(ss, lane);
        const float r = rsqrtf(ss * (1.f / D) + 1e-6f);
#pragma unroll
        for (int i = 0; i < 4; ++i) { const int col = 4 * lane + 256 * i; *(f32x4*)(xr + col) = v[i] * r * *(const f32x4*)(g + col); }
    }
}

__device__ __forceinline__ float log_sigmoidf(float x) { return fminf(x, 0.f) - log1pf(expf(-fabsf(x))); }
__device__ __forceinline__ float fexp(float x) { return __builtin_amdgcn_exp2f(x * 1.4426950408889634f); }
__device__ __forceinline__ float log_sigmoid_fast(float x) { return fminf(x, 0.f) - 0.6931471805599453f * __builtin_amdgcn_logf(1.f + fexp(-fabsf(x))); }
__device__ __forceinline__ float pj(const bf16_t* __restrict__ P, int row, int col) { return bf2f(P[(size_t)row * PL + col]); }
constexpr int GLA_QDT = 0, GLA_KDT = GLA_QDT + 48 * 68 * 4, GLA_ATT = GLA_KDT + 48 * 68 * 4, GLA_V = GLA_ATT + 64 * 68 * 4, GLA_KH = GLA_V + 64 * 100 * 4, GLA_S = GLA_KH + 64 * 52 * 4,
              GLA_BC = GLA_S + 48 * 100 * 4, GLA_DEC = GLA_BC + 64 * 49 * 4, GLA_RED = GLA_DEC + 64 * 4, GLA_PART = GLA_RED + 64 * 24 * 4, GLA_GW = GLA_PART + 8 * 48 * 4, GLA_RR = GLA_GW + 17 * 48 * 4, GLA_END = GLA_RR + 64 * 96 * 2;
static_assert(GLA_END <= 160 * 1024, "GLA LDS");
struct GlaRaw { u32x4 l0, l1, q, k; u32x2 v0, v1, v2, r0, r1, r2; };
template <bool FULL>
__device__ __forceinline__ void gla_load_raw(GlaRaw& R, const bf16_t* __restrict__ P, int t0, int h, int tid) {
    const bf16_t* row = P + (size_t)(t0 + (tid >> 3)) * PL; const int jg = tid & 7;
    { const bf16_t* lrow = P + (size_t)(t0 + (tid & 63)) * PL + OLR; R.l0 = *(const u32x4*)lrow; R.l1 = *(const u32x4*)(lrow + 8); }
    R.k.x = *(const unsigned*)(row + OKK + h * 48 + 6 * jg); R.k.y = *(const unsigned*)(row + OKK + h * 48 + 6 * jg + 2); R.k.z = *(const unsigned*)(row + OKK + h * 48 + 6 * jg + 4); R.k.w = 0u;
    R.v0 = *(const u32x2*)(row + OV + h * 96 + 12 * jg); R.v1 = *(const u32x2*)(row + OV + h * 96 + 12 * jg + 4); R.v2 = *(const u32x2*)(row + OV + h * 96 + 12 * jg + 8);
    R.q = (u32x4){0u, 0u, 0u, 0u}; R.r0 = (u32x2){0u, 0u}; R.r1 = R.r0; R.r2 = R.r0;
    if (FULL) { R.q.x = *(const unsigned*)(row + OQ + h * 48 + 6 * jg); R.q.y = *(const unsigned*)(row + OQ + h * 48 + 6 * jg + 2); R.q.z = *(const unsigned*)(row + OQ + h * 48 + 6 * jg + 4);
        R.r0 = *(const u32x2*)(row + ORR + h * 96 + 12 * jg); R.r1 = *(const u32x2*)(row + ORR + h * 96 + 12 * jg + 4); R.r2 = *(const u32x2*)(row + ORR + h * 96 + 12 * jg + 8); }
}
template <bool FULL>
__device__ __forceinline__ void gla_unit(int unit, int tid, LAS unsigned char* sm, const bf16_t* __restrict__ P, const float* __restrict__ gw, const float* __restrict__ gb, const float* __restrict__ ng,
                                         float* __restrict__ GSUM, bf16_t* __restrict__ CAT) {
    typedef LAS float (*a68_t)[68]; typedef LAS float (*a100_t)[100]; typedef LAS float (*a52_t)[52]; typedef LAS float (*a49_t)[49]; typedef LAS float (*a24_t)[24]; typedef LAS float (*a48_t)[48];
    a68_t qdT = (a68_t)(sm + GLA_QDT); a68_t kdT = (a68_t)(sm + GLA_KDT); a68_t attT = (a68_t)(sm + GLA_ATT); a100_t vs = (a100_t)(sm + GLA_V); a52_t kh = (a52_t)(sm + GLA_KH);
    a100_t Ss = (a100_t)(sm + GLA_S); a49_t bc = (a49_t)(sm + GLA_BC); LAS float* dec = (LAS float*)(sm + GLA_DEC); a24_t red = (a24_t)(sm + GLA_RED); LAS float* part = (LAS float*)(sm + GLA_PART);
    a48_t gwl = (a48_t)(sm + GLA_GW);
    LAS bf16_t* rr = (LAS bf16_t*)(sm + GLA_RR);
    const int seg = unit & 15, h = (unit >> 4) & 3, b = unit >> 6;
    GlaRaw cur; gla_load_raw<FULL>(cur, P, b * L + (seg * 8) * 64, h, tid);
    __syncthreads();
    for (int i = tid; i < 17 * 48; i += 512) { const int r = i / 48, j = i % 48; gwl[r][j] = (r < 16) ? gw[r * 192 + h * 48 + j] : gb[h * 48 + j]; }
    float pdec = 1.f;
    if (FULL) {
        float sv[9];
#pragma unroll
        for (int i = 0; i < 9; ++i) sv[i] = 0.f;
        const float* base = GSUM + (size_t)(unit - seg) * 4672;
#pragma unroll 4
        for (int sp = 0; sp < seg; ++sp) {
            const float* su = base + (size_t)sp * 4672;
#pragma unroll
            for (int i = 0; i < 9; ++i) { const int e = tid + 512 * i; sv[i] = su[4608 + e / 96] * sv[i] + su[e]; }
        }
#pragma unroll
        for (int i = 0; i < 9; ++i) { const int e = tid + 512 * i; Ss[e / 96][e % 96] = sv[i]; }
    } else {
        for (int e = tid; e < 4608; e += 512) Ss[e / 96][e % 96] = 0.f;
    }
    for (int c = 0; c < 8; ++c) {
        const int t0 = b * L + (seg * 8 + c) * 64;
        GlaRaw nxt = cur;
        if (c < 7) gla_load_raw<FULL>(nxt, P, t0 + 64, h, tid);
        int tidc = tid; asm volatile("" : "+v"(tidc));
        const int rt = tidc >> 3, jg = tidc & 7;
        __syncthreads();
        {
            const unsigned lw[8] = {cur.l0.x, cur.l0.y, cur.l0.z, cur.l0.w, cur.l1.x, cur.l1.y, cur.l1.z, cur.l1.w};
            float a[6];
#pragma unroll
            for (int i = 0; i < 6; ++i) a[i] = gwl[16][6 * jg + i];
#pragma unroll
            for (int r = 0; r < 8; ++r) { const float x0 = __uint_as_float(lw[r] << 16), x1 = __uint_as_float(lw[r] & 0xffff0000u);
#pragma unroll
                for (int i = 0; i < 6; ++i) a[i] += x0 * gwl[2 * r][6 * jg + i] + x1 * gwl[2 * r + 1][6 * jg + i]; }
#pragma unroll
            for (int i = 0; i < 6; ++i) bc[rt][6 * jg + i] = log_sigmoid_fast(a[i]) * (1.f / 16.f);
        }
        __syncthreads();
        float loc[8]; const int cj = tidc % 48, cp = tidc / 48;
        if (tidc < 384) { float s = 0.f;
#pragma unroll
            for (int r = 0; r < 8; ++r) { s += bc[cp * 8 + r][cj]; loc[r] = s; }
            part[cp * 48 + cj] = s; }
        __syncthreads();
        if (tidc < 384) { float off = 0.f;
#pragma unroll
            for (int q = 0; q < 8; ++q) off += (q < cp) ? part[q * 48 + cj] : 0.f;
#pragma unroll
            for (int r = 0; r < 8; ++r) bc[cp * 8 + r][cj] = loc[r] + off; }
        __syncthreads();
        {
#pragma unroll
            for (int i = 0; i < 6; ++i) {
                const int j = 6 * jg + i; const float bcv = bc[rt][j], bl = bc[63][j];
                const unsigned kw = (i >> 1) == 0 ? cur.k.x : (i >> 1) == 1 ? cur.k.y : cur.k.z; const float kv = (i & 1) ? __uint_as_float(kw & 0xffff0000u) : __uint_as_float(kw << 16);
                kh[rt][j] = kv * fexp(bl - bcv);
                if (FULL) { const unsigned qw = (i >> 1) == 0 ? cur.q.x : (i >> 1) == 1 ? cur.q.y : cur.q.z; const float qv = (i & 1) ? __uint_as_float(qw & 0xffff0000u) : __uint_as_float(qw << 16);
                    kdT[j][rt] = kv * fexp(-bcv); qdT[j][rt] = qv * 0.14433756729740643f * fexp(bcv); }
            }
#pragma unroll
            for (int i = 0; i < 3; ++i) { const u32x2 w = i == 0 ? cur.v0 : i == 1 ? cur.v1 : cur.v2;
                *(LAS f32x4*)&vs[rt][12 * jg + 4 * i] = (f32x4){__uint_as_float(w.x << 16), __uint_as_float(w.x & 0xffff0000u), __uint_as_float(w.y << 16), __uint_as_float(w.y & 0xffff0000u)};
                if (FULL) *(LAS u32x2*)(rr + rt * 96 + 12 * jg + 4 * i) = (i == 0 ? cur.r0 : i == 1 ? cur.r1 : cur.r2); }
            if (tidc < 48) { const float d = fexp(bc[63][tidc]); dec[tidc] = d; pdec *= d; }
        }
        __syncthreads();
        if (FULL) {
            if (tidc < 256) {
                const int tb = tidc >> 4, sb = tidc & 15;
                if (sb <= tb) {
                    float a[4][4];
#pragma unroll
                    for (int i = 0; i < 4; ++i)
#pragma unroll
                        for (int k = 0; k < 4; ++k) a[i][k] = 0.f;
                    for (int j0 = 0; j0 < 48; j0 += 4) {
                        f32x4 q4[4], k4[4];
#pragma unroll
                        for (int u = 0; u < 4; ++u) { q4[u] = *(const LAS f32x4*)&qdT[j0 + u][4 * tb]; k4[u] = *(const LAS f32x4*)&kdT[j0 + u][4 * sb]; }
#pragma unroll
                        for (int u = 0; u < 4; ++u) { const float qq[4] = {q4[u].x, q4[u].y, q4[u].z, q4[u].w}, kk[4] = {k4[u].x, k4[u].y, k4[u].z, k4[u].w};
#pragma unroll
                            for (int i = 0; i < 4; ++i)
#pragma unroll
                                for (int k = 0; k < 4; ++k) a[i][k] += qq[i] * kk[k]; }
                    }
#pragma unroll
                    for (int k = 0; k < 4; ++k) { f32x4 w; w.x = (4 * sb + k <= 4 * tb + 0) ? a[0][k] : 0.f; w.y = (4 * sb + k <= 4 * tb + 1) ? a[1][k] : 0.f; w.z = (4 * sb + k <= 4 * tb + 2) ? a[2][k] : 0.f; w.w = (4 * sb + k <= 4 * tb + 3) ? a[3][k] : 0.f;
                        *(LAS f32x4*)&attT[4 * sb + k][4 * tb] = w; }
                }
            }
            __syncthreads();
            const int tb = tidc / 24, eb = tidc % 24;
            float o[4][4];
#pragma unroll
            for (int i = 0; i < 4; ++i)
#pragma unroll
                for (int k = 0; k < 4; ++k) o[i][k] = 0.f;
            if (tidc < 384) {
                for (int s0 = 0; s0 < 4 * tb + 4; s0 += 4) {
                    f32x4 a4[4], v4[4];
#pragma unroll
                    for (int u = 0; u < 4; ++u) { a4[u] = *(const LAS f32x4*)&attT[s0 + u][4 * tb]; v4[u] = *(const LAS f32x4*)&vs[s0 + u][4 * eb]; }
#pragma unroll
                    for (int u = 0; u < 4; ++u) { const float aa[4] = {a4[u].x, a4[u].y, a4[u].z, a4[u].w}, vv[4] = {v4[u].x, v4[u].y, v4[u].z, v4[u].w};
#pragma unroll
                        for (int i = 0; i < 4; ++i)
#pragma unroll
                            for (int k = 0; k < 4; ++k) o[i][k] += aa[i] * vv[k]; }
                }
                for (int d0 = 0; d0 < 48; d0 += 4) {
                    f32x4 q4[4], s4[4];
#pragma unroll
                    for (int u = 0; u < 4; ++u) { q4[u] = *(const LAS f32x4*)&qdT[d0 + u][4 * tb]; s4[u] = *(const LAS f32x4*)&Ss[d0 + u][4 * eb]; }
#pragma unroll
                    for (int u = 0; u < 4; ++u) { const float qq[4] = {q4[u].x, q4[u].y, q4[u].z, q4[u].w}, ss4[4] = {s4[u].x, s4[u].y, s4[u].z, s4[u].w};
#pragma unroll
                        for (int i = 0; i < 4; ++i)
#pragma unroll
                            for (int k = 0; k < 4; ++k) o[i][k] += qq[i] * ss4[k]; }
                }
#pragma unroll
                for (int i = 0; i < 4; ++i) red[4 * tb + i][eb] = o[i][0] * o[i][0] + o[i][1] * o[i][1] + o[i][2] * o[i][2] + o[i][3] * o[i][3];
            }
            __syncthreads();
            if (tidc < 384) {
                const f32x4 g4 = *(const f32x4*)(ng + 4 * eb);
#pragma unroll
                for (int i = 0; i < 4; ++i) {
                    const int t = 4 * tb + i; float ssum = 0.f;
#pragma unroll
                    for (int q = 0; q < 24; ++q) ssum += red[t][q];
                    const float rn = rsqrtf(ssum * (1.f / 96.f) + 1e-6f);
                    const u32x2 rw = *(const LAS u32x2*)(rr + t * 96 + 4 * eb);
                    const float r0 = __uint_as_float(rw.x << 16), r1 = __uint_as_float(rw.x & 0xffff0000u), r2 = __uint_as_float(rw.y << 16), r3 = __uint_as_float(rw.y & 0xffff0000u);
                    u32x2 w; w.x = pk2(o[i][0] * rn * g4.x * siluf(r0), o[i][1] * rn * g4.y * siluf(r1)); w.y = pk2(o[i][2] * rn * g4.z * siluf(r2), o[i][3] * rn * g4.w * siluf(r3));
                    *(u32x2*)(CAT + (size_t)(t0 + t) * D + h * 96 + 4 * eb) = w;
                }
            }
        }
        if (tidc < 288) {
            const int db = tidc / 24, eb = tidc % 24;
            float u[4][4];
#pragma unroll
            for (int i = 0; i < 4; ++i)
#pragma unroll
                for (int k = 0; k < 4; ++k) u[i][k] = 0.f;
            for (int tq0 = 0; tq0 < 64; tq0 += 4) {
                f32x4 k4[4], v4[4];
#pragma unroll
                for (int u2 = 0; u2 < 4; ++u2) { k4[u2] = *(const LAS f32x4*)&kh[tq0 + u2][4 * db]; v4[u2] = *(const LAS f32x4*)&vs[tq0 + u2][4 * eb]; }
#pragma unroll
                for (int u2 = 0; u2 < 4; ++u2) { const float kk[4] = {k4[u2].x, k4[u2].y, k4[u2].z, k4[u2].w}, vv[4] = {v4[u2].x, v4[u2].y, v4[u2].z, v4[u2].w};
#pragma unroll
                    for (int i = 0; i < 4; ++i)
#pragma unroll
                        for (int k = 0; k < 4; ++k) u[i][k] += kk[i] * vv[k]; }
            }
#pragma unroll
            for (int i = 0; i < 4; ++i) { const float dd = dec[4 * db + i]; f32x4 s4 = *(const LAS f32x4*)&Ss[4 * db + i][4 * eb];
                s4.x = dd * s4.x + u[i][0]; s4.y = dd * s4.y + u[i][1]; s4.z = dd * s4.z + u[i][2]; s4.w = dd * s4.w + u[i][3];
                *(LAS f32x4*)&Ss[4 * db + i][4 * eb] = s4; }
        }
        cur = nxt;
    }
    if (!FULL) {
        __syncthreads();
        float* su = GSUM + (size_t)unit * 4672;
        for (int e = tid; e < 4608; e += 512) su[e] = Ss[e / 96][e % 96];
        if (tid < 48) su[4608 + tid] = pdec;
    }
}

typedef float f32x2_t __attribute__((ext_vector_type(2)));
struct S5Coef { float lr, li; f32x2_t bb[16]; };
__device__ __forceinline__ void s5_coef(const float* __restrict__ tab, const float* __restrict__ a_im, const float* __restrict__ log_step, const float* __restrict__ b_re, const float* __restrict__ b_im, int g, int p, S5Coef& C) {
    (void)a_im; (void)log_step;
    const float4 t4 = ((const float4*)tab)[g * 64 + p];
    C.lr = t4.x; C.li = t4.y;
    const float cr = t4.z, ci = t4.w;
#pragma unroll
    for (int c4 = 0; c4 < 4; ++c4) { const float4 br4 = *(const float4*)(b_re + (g * 64 + p) * 16 + 4 * c4), bi4 = *(const float4*)(b_im + (g * 64 + p) * 16 + 4 * c4);
        const float brv[4] = {br4.x, br4.y, br4.z, br4.w}, biv[4] = {bi4.x, bi4.y, bi4.z, bi4.w};
#pragma unroll
        for (int k = 0; k < 4; ++k) C.bb[4 * c4 + k] = (f32x2_t){cr * brv[k] - ci * biv[k], cr * biv[k] + ci * brv[k]}; }
}
__device__ __forceinline__ float gelu_tanh(float x) { const float u = 0.7978845608028654f * (x + 0.044715f * x * x * x); return x * fsigmoid(2.f * u); }
typedef float f32x4m_t __attribute__((ext_vector_type(4)));
constexpr int S5_YT = 0, S5_YSTR = 784, S5_UT = 128 * S5_YSTR, S5_HT = S5_UT + 8 * 2048, S5_HSTR = 272, S5_SSP = S5_HT + 8 * 16 * S5_HSTR, S5_RSTD = S5_SSP + 8 * 128 * 4, S5_END = S5_RSTD + 128 * 4;
static_assert(S5_END <= 160 * 1024, "S5 LDS");
template <bool P2>
__device__ __forceinline__ void s5_unit(int unit, int tid, LAS unsigned char* sm, const bf16_t* __restrict__ P, const float* __restrict__ a_re, const float* __restrict__ a_im, const float* __restrict__ log_step,
                                        const float* __restrict__ b_re, const float* __restrict__ b_im, const float* __restrict__ c_re, const float* __restrict__ c_im, const float* __restrict__ dd,
                                        float* __restrict__ E, const bf16_t* __restrict__ GLUT, const float* __restrict__ glub, const float* __restrict__ ng, bf16_t* __restrict__ CAT,
                                        const bf16_t* __restrict__ HNA = nullptr, const bf16_t* __restrict__ WB = nullptr, bf16_t* __restrict__ PW = nullptr) {
    const int wave = __builtin_amdgcn_readfirstlane(tid >> 6), lane = tid & 63, b = unit >> 6, seg = unit & 63, t0 = b * L + seg * 128;
    if (!P2) {
        constexpr int BST = 2064;
        __syncthreads();
#pragma unroll
        for (int it = 0; it < 16; ++it) { const int ch = it * 8 + wave, n = ch >> 1, hf = ch & 1;
            __builtin_amdgcn_global_load_lds((const unsigned*)(WB + (size_t)n * 1024 + hf * 512 + lane * 8), (LAS unsigned*)(sm + n * BST + hf * 1024), 16, 0, 0); }
        asm volatile("s_waitcnt vmcnt(0)" ::: "memory");
        __syncthreads();
        const int mr = lane & 15, mq = lane >> 4;
        const bf16_t* ap = HNA + (size_t)(t0 + 16 * wave + mr) * 1024 + 8 * mq;
        f32x4m_t acc0 = {0.f, 0.f, 0.f, 0.f}, acc1 = acc0, acc2 = acc0, acc3 = acc0;
#pragma unroll 1
        for (int kh = 0; kh < 2; ++kh) {
            u32x4 av[16];
#pragma unroll
            for (int i = 0; i < 16; ++i) av[i] = *(const u32x4*)(ap + 32 * (16 * kh + i));
#pragma unroll
            for (int i = 0; i < 16; ++i) {
                const int ks = 16 * kh + i;
                const bf16x8_t a = __builtin_bit_cast(bf16x8_t, av[i]);
                const LAS unsigned char* bp = sm + mr * BST + (32 * ks + 8 * mq) * 2;
                const bf16x8_t b0 = *(const LAS bf16x8_t*)bp, b1 = *(const LAS bf16x8_t*)(bp + 16 * BST), b2 = *(const LAS bf16x8_t*)(bp + 32 * BST), b3 = *(const LAS bf16x8_t*)(bp + 48 * BST);
                acc0 = __builtin_amdgcn_mfma_f32_16x16x32_bf16(b0, a, acc0, 0, 0, 0); acc1 = __builtin_amdgcn_mfma_f32_16x16x32_bf16(b1, a, acc1, 0, 0, 0);
                acc2 = __builtin_amdgcn_mfma_f32_16x16x32_bf16(b2, a, acc2, 0, 0, 0); acc3 = __builtin_amdgcn_mfma_f32_16x16x32_bf16(b3, a, acc3, 0, 0, 0);
            }
        }
        bf16_t* op = PW + (size_t)(t0 + 16 * wave + mr) * PL + 2560 + 4 * mq;
        { u32x2 w; w.x = pk2(acc0[0], acc0[1]); w.y = pk2(acc0[2], acc0[3]); *(u32x2*)(op) = w; }
        { u32x2 w; w.x = pk2(acc1[0], acc1[1]); w.y = pk2(acc1[2], acc1[3]); *(u32x2*)(op + 16) = w; }
        { u32x2 w; w.x = pk2(acc2[0], acc2[1]); w.y = pk2(acc2[2], acc2[3]); *(u32x2*)(op + 32) = w; }
        { u32x2 w; w.x = pk2(acc3[0], acc3[1]); w.y = pk2(acc3[2], acc3[3]); *(u32x2*)(op + 48) = w; }
        __threadfence_block();
    }
    LAS unsigned char* Yt = sm + S5_YT;
    LAS float* ut = (LAS float*)(sm + S5_UT + wave * 2048);
    LAS unsigned char* Ht = sm + S5_HT + wave * 16 * S5_HSTR;
    const int fr = lane & 15, fq = lane >> 4;
    float c0r = 0.f, c0i = 0.f, c1r = 0.f, c1i = 0.f, c2r = 0.f, c2i = 0.f;
    if (P2) {
        float L0r, L0i, L1r, L1i, L2r, L2i;
#define S5_LAM(gi_, Lr_, Li_) do { const float4 t4_ = ((const float4*)a_re)[(3 * wave + (gi_)) * 64 + lane]; Lr_ = t4_.x; Li_ = t4_.y; \
            _Pragma("unroll") for (int i = 0; i < 7; ++i) { const float nr_ = Lr_ * Lr_ - Li_ * Li_, ni_ = 2.f * Lr_ * Li_; Lr_ = nr_; Li_ = ni_; } } while (0)
        S5_LAM(0, L0r, L0i); S5_LAM(1, L1r, L1i); S5_LAM(2, L2r, L2i);
#undef S5_LAM
        const float* ep = E + ((size_t)(unit - seg) * 24 + 3 * wave) * 128 + 2 * lane;
#pragma unroll 8
        for (int sp = 0; sp < seg; ++sp) {
            const float2 e0 = *(const float2*)(ep + (size_t)sp * 24 * 128), e1 = *(const float2*)(ep + (size_t)sp * 24 * 128 + 128), e2 = *(const float2*)(ep + (size_t)sp * 24 * 128 + 256);
            { const float nr = L0r * c0r - L0i * c0i + e0.x, ni = L0r * c0i + L0i * c0r + e0.y; c0r = nr; c0i = ni; }
            { const float nr = L1r * c1r - L1i * c1i + e1.x, ni = L1r * c1i + L1i * c1r + e1.y; c1r = nr; c1i = ni; }
            { const float nr = L2r * c2r - L2i * c2i + e2.x, ni = L2r * c2i + L2i * c2r + e2.y; c2r = nr; c2i = ni; }
        }
    }
    __syncthreads();
    for (int gi = 0; gi < 3; ++gi) {
        const int g = 3 * wave + gi;
        S5Coef C; s5_coef(a_re, a_im, log_step, b_re, b_im, g, lane, C);
        float hr = gi == 0 ? c0r : gi == 1 ? c1r : c2r, hi = gi == 0 ? c0i : gi == 1 ? c1i : c2i;
        bf16x8_t cfr[4]; float dco = 0.f;
        if (P2) {
#pragma unroll
            for (int ks = 0; ks < 4; ++ks) {
                const size_t co = (size_t)(g * 16 + fr) * 64 + 16 * ks + 4 * fq;
                const float4 vr = *(const float4*)(c_re + co), vi = *(const float4*)(c_im + co);
                u32x4 w; w.x = pk2(vr.x, -vi.x); w.y = pk2(vr.y, -vi.y); w.z = pk2(vr.z, -vi.z); w.w = pk2(vr.w, -vi.w);
                cfr[ks] = __builtin_bit_cast(bf16x8_t, w);
            }
            dco = dd[g * 16 + fr];
        }
        u32x4 unext = *(const u32x4*)(P + (size_t)(t0 + (lane >> 1)) * PL + SU + 16 * g + 8 * (lane & 1));
        for (int tb = 0; tb < 4; ++tb) {
            { const u32x4 w = unext;
              if (tb < 3) unext = *(const u32x4*)(P + (size_t)(t0 + (tb + 1) * 32 + (lane >> 1)) * PL + SU + 16 * g + 8 * (lane & 1));
              LAS f32x4* dst = (LAS f32x4*)(ut + (lane >> 1) * 16 + 8 * (lane & 1));
              dst[0] = (f32x4){__uint_as_float(w.x << 16), __uint_as_float(w.x & 0xffff0000u), __uint_as_float(w.y << 16), __uint_as_float(w.y & 0xffff0000u)};
              dst[1] = (f32x4){__uint_as_float(w.z << 16), __uint_as_float(w.z & 0xffff0000u), __uint_as_float(w.w << 16), __uint_as_float(w.w & 0xffff0000u)}; }
            asm volatile("s_waitcnt lgkmcnt(0)" ::: "memory");
#pragma unroll 1
            for (int hb = 0; hb < 2; ++hb) {
                const LAS f32x4* upb = (const LAS f32x4*)(ut + (hb * 16) * 16);
                f32x4 nu0 = upb[0], nu1 = upb[1], nu2 = upb[2], nu3 = upb[3];
#pragma unroll
                for (int tt = 0; tt < 16; ++tt) {
                    const f32x4 u0 = nu0, u1 = nu1, u2 = nu2, u3 = nu3;
                    if (tt < 15) { nu0 = upb[4 * (tt + 1)]; nu1 = upb[4 * (tt + 1) + 1]; nu2 = upb[4 * (tt + 1) + 2]; nu3 = upb[4 * (tt + 1) + 3]; }
                    const float uu[16] = {u0.x, u0.y, u0.z, u0.w, u1.x, u1.y, u1.z, u1.w, u2.x, u2.y, u2.z, u2.w, u3.x, u3.y, u3.z, u3.w};
                    f32x2_t xa = {0.f, 0.f}, xb = {0.f, 0.f};
#pragma unroll
                    for (int c = 0; c < 16; c += 2) { xa += (f32x2_t){uu[c], uu[c]} * C.bb[c]; xb += (f32x2_t){uu[c + 1], uu[c + 1]} * C.bb[c + 1]; }
                    const f32x2_t hv = {hr, hi}, hs = {hi, hr};
                    const f32x2_t hn = (xa + xb) + (f32x2_t){C.lr, C.lr} * hv + (f32x2_t){-C.li, C.li} * hs;
                    hr = hn.x; hi = hn.y;
                    if (P2) *(LAS unsigned*)(Ht + tt * S5_HSTR + lane * 4) = pk2(hr, hi);
                }
                if (P2) {
                    asm volatile("s_waitcnt lgkmcnt(0)" ::: "memory");
                    f32x4m_t acc = {0.f, 0.f, 0.f, 0.f};
#pragma unroll
                    for (int ks = 0; ks < 4; ++ks) { const bf16x8_t a = *(const LAS bf16x8_t*)(Ht + fr * S5_HSTR + (32 * ks + 8 * fq) * 2); acc = __builtin_amdgcn_mfma_f32_16x16x32_bf16(a, cfr[ks], acc, 0, 0, 0); }
#pragma unroll
                    for (int r = 0; r < 4; ++r) { const int tl = hb * 16 + 4 * fq + r; const float y = acc[r] + dco * ut[tl * 16 + fr];
                        *(LAS bf16_t*)(Yt + (tb * 32 + tl) * S5_YSTR + (16 * g + fr) * 2) = (bf16_t)f2bf(gelu_tanh(y)); }
                    asm volatile("s_waitcnt lgkmcnt(0)" ::: "memory");
                }
            }
        }
        if (!P2) { float* eo = E + ((size_t)unit * 24 + g) * 128 + 2 * lane; eo[0] = hr; eo[1] = hi; }
    }
    if (P2) {
        __syncthreads();
        const int j0 = 48 * wave;
        f32x4m_t acc[8][3];
#pragma unroll
        for (int rt = 0; rt < 8; ++rt)
#pragma unroll
            for (int ct = 0; ct < 3; ++ct) acc[rt][ct] = (f32x4m_t){0.f, 0.f, 0.f, 0.f};
        u32x4 bwn0 = *(const u32x4*)(GLUT + (size_t)(j0 + fr) * 384 + 8 * fq), bwn1 = *(const u32x4*)(GLUT + (size_t)(j0 + 16 + fr) * 384 + 8 * fq), bwn2 = *(const u32x4*)(GLUT + (size_t)(j0 + 32 + fr) * 384 + 8 * fq);
#pragma unroll 1
        for (int ks = 0; ks < 12; ++ks) {
            bf16x8_t bw[3];
            bw[0] = __builtin_bit_cast(bf16x8_t, bwn0); bw[1] = __builtin_bit_cast(bf16x8_t, bwn1); bw[2] = __builtin_bit_cast(bf16x8_t, bwn2);
            if (ks < 11) { const bf16_t* gp = GLUT + (size_t)(j0 + fr) * 384 + 32 * (ks + 1) + 8 * fq; bwn0 = *(const u32x4*)gp; bwn1 = *(const u32x4*)(gp + 16 * 384); bwn2 = *(const u32x4*)(gp + 32 * 384); }
#pragma unroll
            for (int rt = 0; rt < 8; ++rt) { const bf16x8_t a = *(const LAS bf16x8_t*)(Yt + (16 * rt + fr) * S5_YSTR + (32 * ks + 8 * fq) * 2);
#pragma unroll
                for (int ct = 0; ct < 3; ++ct) acc[rt][ct] = __builtin_amdgcn_mfma_f32_16x16x32_bf16(a, bw[ct], acc[rt][ct], 0, 0, 0); }
        }
        LAS float* ssp = (LAS float*)(sm + S5_SSP); LAS float* rstd = (LAS float*)(sm + S5_RSTD);
        float gb3[3], gn3[3];
#pragma unroll
        for (int ct = 0; ct < 3; ++ct) { gb3[ct] = glub[j0 + 16 * ct + fr]; gn3[ct] = ng[j0 + 16 * ct + fr]; }
#pragma unroll
        for (int rt = 0; rt < 8; ++rt)
#pragma unroll
            for (int r = 0; r < 4; ++r) { const int t = 16 * rt + 4 * fq + r; float s = 0.f;
#pragma unroll
                for (int ct = 0; ct < 3; ++ct) { const float yv = bf2f(*(const LAS bf16_t*)(Yt + t * S5_YSTR + (j0 + 16 * ct + fr) * 2)); const float z = yv * fsigmoid(acc[rt][ct][r] + gb3[ct]); acc[rt][ct][r] = z; s += z * z; }
                s = row_sum16(s);
                if (fr == 0) ssp[wave * 128 + t] = s; }
        __syncthreads();
        if (tid < 128) { float s = 0.f;
#pragma unroll
            for (int w8 = 0; w8 < 8; ++w8) s += ssp[w8 * 128 + tid];
            rstd[tid] = rsqrtf(s * (1.f / 384.f) + 1e-6f); }
        __syncthreads();
#pragma unroll
        for (int rt = 0; rt < 8; ++rt)
#pragma unroll
            for (int r = 0; r < 4; ++r) { const int t = 16 * rt + 4 * fq + r; const float rn = rstd[t];
#pragma unroll
                for (int ct = 0; ct < 3; ++ct) *(LAS bf16_t*)(Yt + t * S5_YSTR + (j0 + 16 * ct + fr) * 2) = (bf16_t)f2bf(acc[rt][ct][r] * rn * gn3[ct]); }
        __syncthreads();
        for (int i = tid; i < 128 * 48; i += 512) { const int t = i / 48, ch = i % 48; *(u32x4*)(CAT + (size_t)(t0 + t) * D + 640 + 8 * ch) = *(const LAS u32x4*)(Yt + t * S5_YSTR + 16 * ch); }
    }
}

__device__ __forceinline__ float relu1(float x) { return __builtin_amdgcn_fmed3f(x, 0.f, __builtin_inff()); }
__device__ __forceinline__ unsigned qbin_of_key(unsigned u) {
    const unsigned bits = (u & 0x80000000u) ? (u & 0x7fffffffu) : ~u;
    const float f = __uint_as_float(bits);
    return (unsigned)(int)fminf(fmaxf((f + 4.0f) * 64.0f, 0.f), 1023.f);
}
struct TkPre { u32x4 af0, af1; f32x4 w0, w1, w2, w3; u32x4 b00, b01, b02, b03, b10, b11, b12, b13; };
__device__ __forceinline__ void topk_prefetch(TkPre& R, int vb, const bf16_t* __restrict__ P, const bf16_t* __restrict__ IKC, const int tid) {
    const int wv = tid >> 6, lane = tid & 63, hl = lane >> 5, row = lane & 31, qi_a = row >> 3, hh_a = row & 7;
    const int t0 = vb * 4, b = t0 / L, tl0 = t0 % L, ntiles = (tl0 + 3) / 32 + 1;
    const bf16_t* ap = P + (size_t)(t0 + qi_a) * PL + IQ + hh_a * 32 + 8 * hl;
    R.af0 = *(const u32x4*)ap; R.af1 = *(const u32x4*)(ap + 16);
    const float4 x0 = ld4bf(P + (size_t)(t0 + 0) * PL + IW + 4 * hl), x1 = ld4bf(P + (size_t)(t0 + 1) * PL + IW + 4 * hl), x2 = ld4bf(P + (size_t)(t0 + 2) * PL + IW + 4 * hl), x3 = ld4bf(P + (size_t)(t0 + 3) * PL + IW + 4 * hl);
    R.w0 = (f32x4){x0.x, x0.y, x0.z, x0.w} * 0.0625f; R.w1 = (f32x4){x1.x, x1.y, x1.z, x1.w} * 0.0625f; R.w2 = (f32x4){x2.x, x2.y, x2.z, x2.w} * 0.0625f; R.w3 = (f32x4){x3.x, x3.y, x3.z, x3.w} * 0.0625f;
    const bf16_t* ikb = IKC + (size_t)b * L * 32 + 8 * hl;
#define TKP_(u_, d0_, d1_) { int tile_ = wv + 8 * (u_); tile_ = tile_ < ntiles ? tile_ : ntiles - 1; const bf16_t* kp_ = ikb + (size_t)(tile_ * 32 + row) * 32; d0_ = *(const u32x4*)kp_; d1_ = *(const u32x4*)(kp_ + 16); }
    TKP_(0, R.b00, R.b10) TKP_(1, R.b01, R.b11) TKP_(2, R.b02, R.b12) TKP_(3, R.b03, R.b13)
#undef TKP_
}
__device__ __forceinline__ void vb_dsa_topk(int vb, int vb_next, TkPre& PR, LAS unsigned char* sm, const bf16_t* __restrict__ P, const bf16_t* __restrict__ IKC, unsigned long long* __restrict__ MASK, const int tid) {
    constexpr int CAP = 256;
    LAS unsigned* keys = (LAS unsigned*)sm;
    LAS unsigned* hist = (LAS unsigned*)(sm + 131072);
    LAS unsigned* lmask = hist + 4096;
    LAS unsigned* clist = lmask + 1024;
    LAS unsigned* bsel = clist + 4 * CAP * 2;
    const int wv = tid >> 6, w = wv >> 1, hf = wv & 1, lane = tid & 63;
    const int t = vb * 4 + w, b = t / L, tl = t % L, n = tl + 1;
    __syncthreads();
    for (int i = tid; i < 4096; i += 512) hist[i] = 0u;
    for (int i = tid; i < 1024; i += 512) lmask[i] = 0u;
    if (tid < 32) bsel[tid] = 0u;
    __syncthreads();
    {
        const int t0 = vb * 4, hl = lane >> 5, row = lane & 31, tl0 = t0 % L;
        bf16x8_t af[2]; af[0] = __builtin_bit_cast(bf16x8_t, PR.af0); af[1] = __builtin_bit_cast(bf16x8_t, PR.af1);
        const f32x4 wv4[4] = {PR.w0, PR.w1, PR.w2, PR.w3};
        const int ntiles = (tl0 + 3) / 32 + 1;
        const bf16_t* ikb = IKC + (size_t)b * L * 32 + 8 * hl;
        u32x4 nb0[4] = {PR.b00, PR.b01, PR.b02, PR.b03}, nb1[4] = {PR.b10, PR.b11, PR.b12, PR.b13};
#define TOPK_LOAD(tg_) do { _Pragma("unroll") for (int u = 0; u < 4; ++u) { int tile_ = (tg_) + 8 * u; tile_ = tile_ < ntiles ? tile_ : ntiles - 1; const bf16_t* kp_ = ikb + (size_t)(tile_ * 32 + row) * 32; nb0[u] = *(const u32x4*)kp_; nb1[u] = *(const u32x4*)(kp_ + 16); } } while (0)
        for (int tg = wv; tg < ntiles; tg += 32) {
            u32x4 cb0[4], cb1[4];
#pragma unroll
            for (int u = 0; u < 4; ++u) { cb0[u] = nb0[u]; cb1[u] = nb1[u]; }
            if (tg + 32 < ntiles) TOPK_LOAD(tg + 32);
#pragma unroll
            for (int u = 0; u < 4; ++u) {
                const int tile = tg + 8 * u, key = tile * 32 + row;
                f32x16_t c;
#pragma unroll
                for (int r = 0; r < 16; ++r) c[r] = 0.f;
                c = __builtin_amdgcn_mfma_f32_32x32x16_bf16(af[0], __builtin_bit_cast(bf16x8_t, cb0[u]), c, 0, 0, 0);
                c = __builtin_amdgcn_mfma_f32_32x32x16_bf16(af[1], __builtin_bit_cast(bf16x8_t, cb1[u]), c, 0, 0, 0);
                float sc4[4];
#pragma unroll
                for (int qi = 0; qi < 4; ++qi) {
                    float part = wv4[qi].x * relu1(c[qi * 4 + 0]) + wv4[qi].y * relu1(c[qi * 4 + 1]) + wv4[qi].z * relu1(c[qi * 4 + 2]) + wv4[qi].w * relu1(c[qi * 4 + 3]);
                    part += shx(part, 32, lane);
                    sc4[qi] = part;
                }
                const float sa = hl ? sc4[2] : sc4[0], sb = hl ? sc4[3] : sc4[1];
                unsigned ua = __float_as_uint(sa + 0.0f), ub = __float_as_uint(sb + 0.0f);
                ua = (ua & 0x80000000u) ? ~ua : (ua | 0x80000000u); ub = (ub & 0x80000000u) ? ~ub : (ub | 0x80000000u);
                if (tile < ntiles) {
                    keys[(2 * hl) * 8192 + key] = ua; keys[(2 * hl + 1) * 8192 + key] = ub;
                    if (key <= tl0 + 2 * hl) __hip_atomic_fetch_add(&hist[(2 * hl) * 1024 + qbin_of_key(ua)], 1u, __ATOMIC_RELAXED, __HIP_MEMORY_SCOPE_WORKGROUP);
                    if (key <= tl0 + 2 * hl + 1) __hip_atomic_fetch_add(&hist[(2 * hl + 1) * 1024 + qbin_of_key(ub)], 1u, __ATOMIC_RELAXED, __HIP_MEMORY_SCOPE_WORKGROUP);
                }
            }
        }
#undef TOPK_LOAD
    }
    if (vb_next >= 0) topk_prefetch(PR, vb_next, P, IKC, tid);
    LAS unsigned* kw = keys + w * 8192;
    __syncthreads();
    const bool need_sel = n > 256;
    if (need_sel && hf == 0) {
        const LAS u32x4* h1 = (const LAS u32x4*)(hist + w * 1024 + 16 * lane);
        unsigned cs[16]; unsigned tot = 0u;
#pragma unroll
        for (int i = 0; i < 4; ++i) { const u32x4 v4 = h1[i]; cs[4 * i] = v4.x; cs[4 * i + 1] = v4.y; cs[4 * i + 2] = v4.z; cs[4 * i + 3] = v4.w; tot += v4.x + v4.y + v4.z + v4.w; }
        unsigned incl = tot;
#pragma unroll
        for (int o = 1; o < 64; o <<= 1) { const unsigned v = shdnu(incl, o, lane); if (lane + o < 64) incl += v; }
        unsigned cum = incl - tot;
#pragma unroll
        for (int i = 15; i >= 0; --i) {
            if (cum < 256u && cum + cs[i] >= 256u) { bsel[w * 4 + 0] = 16u * lane + i; bsel[w * 4 + 1] = 256u - cum; bsel[w * 4 + 2] = cs[i]; if (cs[i] > (unsigned)CAP && cs[i] != 256u - cum) bsel[20] = 1u; }
            cum += cs[i];
        }
    }
    __syncthreads();
    unsigned bstar = 0u, krem = 256u, ties = 0u, prefix = 0u;
    if (need_sel) { bstar = bsel[w * 4 + 0]; krem = bsel[w * 4 + 1]; ties = bsel[w * 4 + 2]; }
    const bool refine = need_sel && (ties != krem);
    const bool use_list = refine && ties <= (unsigned)CAP;
    const bool any_fallback = bsel[20] != 0u;
    __syncthreads();
    unsigned long long cbits = 0ull;
    for (int j = hf, jl = 0; j < 32; j += 2, ++jl) {
        if (j * 256 >= n) break;
        unsigned long long bal[4];
#pragma unroll
        for (int c = 0; c < 4; ++c) {
            const int s = j * 256 + c * 64 + lane;
            const unsigned u = kw[s]; const unsigned qb = qbin_of_key(u);
            const bool in = s < n;
            const bool sure = in && (!need_sel || qb > bstar || (!refine && qb == bstar));
            bal[c] = __ballot(sure);
            if (use_list && in && qb == bstar) cbits |= 1ull << (4 * jl + c);
        }
        if (lane < 4) { const unsigned long long v = lane == 0 ? bal[0] : lane == 1 ? bal[1] : lane == 2 ? bal[2] : bal[3];
            lmask[w * 256 + (j * 4 + lane) * 2] = (unsigned)v; lmask[w * 256 + (j * 4 + lane) * 2 + 1] = (unsigned)(v >> 32); }
    }
    if (use_list) {
        const unsigned mine = (unsigned)__popcll(cbits);
        unsigned incl = mine;
#pragma unroll
        for (int o = 1; o < 64; o <<= 1) { const unsigned v = (unsigned)shupi((int)incl, o, lane); if (lane >= o) incl += v; }
        unsigned base = 0u;
        if (lane == 63) base = __hip_atomic_fetch_add(&bsel[16 + w], incl, __ATOMIC_RELAXED, __HIP_MEMORY_SCOPE_WORKGROUP);
        base = shidxu(base, 63) + incl - mine;
        while (cbits) {
            const int bit = __ffsll((long long)cbits) - 1; cbits &= cbits - 1ull;
            const int s = (hf + 2 * (bit >> 2)) * 256 + (bit & 3) * 64 + lane;
            *(LAS u32x2*)(clist + (w * CAP + base) * 2) = (u32x2){kw[s], (unsigned)s}; ++base;
        }
    }
    __syncthreads();
    if (use_list) {
        const unsigned mcnt = ties;
        for (unsigned i = lane + 64 * hf; i < mcnt; i += 128) {
            const u32x2 me = *(const LAS u32x2*)(clist + (w * CAP + i) * 2);
            unsigned rank = 0u;
#pragma unroll 8
            for (unsigned jj = 0; jj < mcnt; ++jj) { const u32x2 o2 = *(const LAS u32x2*)(clist + (w * CAP + jj) * 2); rank += (o2.x > me.x || (o2.x == me.x && o2.y < me.y)) ? 1u : 0u; }
            if (rank < krem) __hip_atomic_fetch_or(&lmask[w * 256 + (me.y >> 5)], 1u << (me.y & 31u), __ATOMIC_RELAXED, __HIP_MEMORY_SCOPE_WORKGROUP);
        }
    }
    __syncthreads();
    if (any_fallback) {
        const bool rf = refine && !use_list;
        LAS unsigned* hw = hist + w * 1024;
        for (int pass = 3; pass >= 0; --pass) {
            for (int i = lane + 64 * hf; i < 256; i += 128) hw[i] = 0u;
            __syncthreads();
            if (rf) {
                const int sh = pass * 8;
                for (int s = lane + 64 * hf; s < n; s += 128) {
                    const unsigned u = kw[s];
                    const bool match = (qbin_of_key(u) == bstar) && ((pass == 3) || ((u >> (sh + 8)) == prefix));
                    if (match) __hip_atomic_fetch_add(&hw[(u >> sh) & 255u], 1u, __ATOMIC_RELAXED, __HIP_MEMORY_SCOPE_WORKGROUP);
                }
            }
            __syncthreads();
            if (rf && hf == 0) {
                const unsigned c0 = hw[4 * lane], c1 = hw[4 * lane + 1], c2 = hw[4 * lane + 2], c3 = hw[4 * lane + 3];
                const unsigned tot = c0 + c1 + c2 + c3;
                unsigned incl = tot;
#pragma unroll
                for (int o = 1; o < 64; o <<= 1) { const unsigned v = shdnu(incl, o, lane); if (lane + o < 64) incl += v; }
                unsigned cum = incl - tot;
                const unsigned cs[4] = {c0, c1, c2, c3};
#pragma unroll
                for (int i = 3; i >= 0; --i) {
                    if (cum < krem && cum + cs[i] >= krem) { bsel[w * 4 + 0] = 4u * lane + i; bsel[w * 4 + 1] = krem - cum; bsel[w * 4 + 2] = cs[i]; }
                    cum += cs[i];
                }
            }
            __syncthreads();
            if (rf) { prefix = (prefix << 8) | bsel[w * 4 + 0]; krem = bsel[w * 4 + 1]; ties = bsel[w * 4 + 2]; }
            __syncthreads();
        }
        if (rf && hf == 0) {
            unsigned running = 0u;
            for (int j = 0; j < 128; ++j) {
                const int s = j * 64 + lane;
                const unsigned u = (s < n) ? kw[s] : 0u; const unsigned qb = qbin_of_key(u);
                const bool gt = (s < n) && qb == bstar && u > prefix, eq = (s < n) && qb == bstar && u == prefix;
                const unsigned long long em = __ballot(eq);
                const unsigned rank = running + (unsigned)__popcll(em & ((1ull << lane) - 1ull));
                const bool sel = gt || (eq && rank < krem);
                running += (unsigned)__popcll(em);
                const unsigned long long mm = __ballot(sel);
                if (lane == 0 && mm) { __hip_atomic_fetch_or(&lmask[w * 256 + j * 2], (unsigned)mm, __ATOMIC_RELAXED, __HIP_MEMORY_SCOPE_WORKGROUP); __hip_atomic_fetch_or(&lmask[w * 256 + j * 2 + 1], (unsigned)(mm >> 32), __ATOMIC_RELAXED, __HIP_MEMORY_SCOPE_WORKGROUP); }
            }
        }
        __syncthreads();
    }
    { const int j = lane + 64 * hf; u32x2 v; v.x = lmask[w * 256 + 2 * j]; v.y = lmask[w * 256 + 2 * j + 1]; *(u32x2*)(MASK + (size_t)t * 128 + j) = v; }
}
constexpr int TK4_CAP = 1024, TK4_TARGET = 55, TK4_LIST = 0, TK4_MASK = 65536, TK4_H2 = TK4_MASK + 8192, TK4_PAR = TK4_H2 + 32768, TK4_CL = TK4_PAR + 1024, TK4_END = TK4_CL + 8 * 64 * 8;
static_assert(TK4_END <= 160 * 1024, "topk v4 LDS");
__device__ __forceinline__ unsigned tk4_key(float f) { const unsigned u = __float_as_uint(f + 0.0f); return u ^ ((unsigned)((int)u >> 31) | 0x80000000u); }
struct Tk4Ops { u32x4 a00, a01, a10, a11, a20, a21; f32x4 w0, w1, w2, w3, w4, w5, w6, w7; };
#define TK4_FMA8(acc_, c_, o_, wa_, wb_) do { \
    acc_ = __builtin_fmaf(wa_.x, __builtin_fabsf(c_[o_ + 0]), acc_); acc_ = __builtin_fmaf(wa_.y, __builtin_fabsf(c_[o_ + 1]), acc_); acc_ = __builtin_fmaf(wa_.z, __builtin_fabsf(c_[o_ + 2]), acc_); acc_ = __builtin_fmaf(wa_.w, __builtin_fabsf(c_[o_ + 3]), acc_); \
    acc_ = __builtin_fmaf(wb_.x, __builtin_fabsf(c_[o_ + 4]), acc_); acc_ = __builtin_fmaf(wb_.y, __builtin_fabsf(c_[o_ + 5]), acc_); acc_ = __builtin_fmaf(wb_.z, __builtin_fabsf(c_[o_ + 6]), acc_); acc_ = __builtin_fmaf(wb_.w, __builtin_fabsf(c_[o_ + 7]), acc_); } while (0)
#define TK4_SCORES(b0_, b1_, F_) do { \
    f32x16_t c0_, c1_, c2_; \
    _Pragma("unroll") for (int r_ = 0; r_ < 16; ++r_) { c0_[r_] = 0.f; c1_[r_] = 0.f; c2_[r_] = 0.f; } \
    c0_ = __builtin_amdgcn_mfma_f32_32x32x16_bf16(__builtin_bit_cast(bf16x8_t, A.a00), __builtin_bit_cast(bf16x8_t, b0_), c0_, 0, 0, 0); \
    c1_ = __builtin_amdgcn_mfma_f32_32x32x16_bf16(__builtin_bit_cast(bf16x8_t, A.a10), __builtin_bit_cast(bf16x8_t, b0_), c1_, 0, 0, 0); \
    c2_ = __builtin_amdgcn_mfma_f32_32x32x16_bf16(__builtin_bit_cast(bf16x8_t, A.a20), __builtin_bit_cast(bf16x8_t, b0_), c2_, 0, 0, 0); \
    c0_ = __builtin_amdgcn_mfma_f32_32x32x16_bf16(__builtin_bit_cast(bf16x8_t, A.a01), __builtin_bit_cast(bf16x8_t, b1_), c0_, 0, 0, 0); \
    c1_ = __builtin_amdgcn_mfma_f32_32x32x16_bf16(__builtin_bit_cast(bf16x8_t, A.a11), __builtin_bit_cast(bf16x8_t, b1_), c1_, 0, 0, 0); \
    c2_ = __builtin_amdgcn_mfma_f32_32x32x16_bf16(__builtin_bit_cast(bf16x8_t, A.a21), __builtin_bit_cast(bf16x8_t, b1_), c2_, 0, 0, 0); \
    float f0_ = c2_[0] + c2_[4], f1_ = c2_[1] + c2_[5], f2_ = c2_[2] + c2_[6], f3_ = c2_[3] + c2_[7]; \
    TK4_FMA8(f0_, c0_, 0, A.w0, A.w1); TK4_FMA8(f1_, c0_, 8, A.w2, A.w3); TK4_FMA8(f2_, c1_, 0, A.w4, A.w5); TK4_FMA8(f3_, c1_, 8, A.w6, A.w7); \
    F_[0] = f0_; F_[1] = f1_; F_[2] = f2_; F_[3] = f3_; \
} while (0)
constexpr int TK5_VAL = 0, TK5_IDX = 32768, TK5_OVF = 65536, TK5_MASK = TK5_OVF + 8192, TK5_H2 = TK5_MASK + 8192, TK5_PAR = TK5_H2 + 32768, TK5_CL = TK5_PAR + 1024, TK5_END = TK5_CL + 8 * 64 * 8;
static_assert(TK5_END <= 160 * 1024, "topk v5 LDS");
constexpr int TK5_PRE = 120832;
__device__ __forceinline__ void tk5_prefetch(int un, LAS unsigned char* sm, const bf16_t* __restrict__ P, int tid) {
    const int wave = __builtin_amdgcn_readfirstlane(tid >> 6), lane = tid & 63;
    if (wave < 4) __builtin_amdgcn_global_load_lds((const unsigned*)(P + (size_t)(un * 8 + 2 * wave + (lane >> 5)) * PL + IQ + (lane & 31) * 8), (LAS unsigned*)(sm + TK5_PRE + wave * 1024), 16, 0, 0);
    else if (wave == 4 && lane < 8) __builtin_amdgcn_global_load_lds((const unsigned*)(P + (size_t)(un * 8 + lane) * PL + IW), (LAS unsigned*)(sm + TK5_PRE + 4096), 16, 0, 0);
}
__device__ __forceinline__ void topk5_unit(int u, int un, LAS unsigned char* sm, const bf16_t* __restrict__ P, const bf16_t* __restrict__ IKC, unsigned long long* __restrict__ MASK, const int tid) {
    LAS unsigned* val = (LAS unsigned*)(sm + TK5_VAL);
    LAS unsigned* hist = val;
    LAS u32x2* ovf = (LAS u32x2*)(sm + TK5_OVF);
    LAS unsigned* lmask = (LAS unsigned*)(sm + TK5_MASK);
    LAS unsigned* h2 = (LAS unsigned*)(sm + TK5_H2);
    LAS float* tau = (LAS float*)(sm + TK5_PAR);
    LAS unsigned* cnt = (LAS unsigned*)(sm + TK5_PAR) + 8;
    LAS unsigned* todo = cnt + 8;
    LAS unsigned* wcnt = todo + 16;
    LAS unsigned* ovc = wcnt + 64;
    const int wv = __builtin_amdgcn_readfirstlane(tid >> 6), lane = tid & 63, hl = lane >> 5, row = lane & 31;
    const int t0 = u * 8, b = t0 / L, tl0 = t0 % L;
    const int ntiles = (tl0 + 7) / 32 + 1;
    unsigned zz_ = 0u; asm volatile("" : "+v"(zz_));
    const u32x4 zero4 = (u32x4){zz_, zz_, zz_, zz_};
    __syncthreads();
    for (int i = tid; i < (32768) / 16; i += 512) ((LAS u32x4*)sm)[i] = zero4;
    for (int i = tid; i < (8192 + 32768) / 16; i += 512) ((LAS u32x4*)(sm + TK5_MASK))[i] = zero4;
    if (tid < 128) ((LAS unsigned*)(sm + TK5_PAR))[tid] = 0u;
    LAS bf16_t* ql = (LAS bf16_t*)(sm + TK5_CL);
    if (tid < 256) { const int Q = tid >> 5, d = tid & 31; const LAS unsigned short* qs = (const LAS unsigned short*)(sm + TK5_PRE) + Q * 256 + d;
        const u32x4 wr = *(const LAS u32x4*)(sm + TK5_PRE + 4096 + Q * 16);
#define TK5_BF(x_) __uint_as_float((unsigned)(x_) << 16)
        float acc = __uint_as_float(wr.x << 16) * TK5_BF(qs[0]) + __uint_as_float(wr.x & 0xffff0000u) * TK5_BF(qs[32]) + __uint_as_float(wr.y << 16) * TK5_BF(qs[64]) + __uint_as_float(wr.y & 0xffff0000u) * TK5_BF(qs[96])
                  + __uint_as_float(wr.z << 16) * TK5_BF(qs[128]) + __uint_as_float(wr.z & 0xffff0000u) * TK5_BF(qs[160]) + __uint_as_float(wr.w << 16) * TK5_BF(qs[192]) + __uint_as_float(wr.w & 0xffff0000u) * TK5_BF(qs[224]);
#undef TK5_BF
        acc *= 0.03125f;
        const unsigned short hi = f2bf(acc); const unsigned short lo = f2bf(acc - __uint_as_float((unsigned)hi << 16));
        ql[(Q * 2 + 0) * 32 + d] = (bf16_t)hi; ql[(Q * 2 + 1) * 32 + d] = (bf16_t)lo; }
    Tk4Ops A;
    { const int qig = 2 * ((row >> 2) & 1) + (row >> 4), hh_a = 4 * ((row >> 3) & 1) + (row & 3);
      const bf16_t* ap0 = P + (size_t)(t0 + qig) * PL + IQ + hh_a * 32 + 8 * hl; const bf16_t* ap1 = ap0 + (size_t)4 * PL;
      A.a00 = *(const u32x4*)ap0; A.a01 = *(const u32x4*)(ap0 + 16); A.a10 = *(const u32x4*)ap1; A.a11 = *(const u32x4*)(ap1 + 16);
#define TK4_W(q_, o_) ({ const float4 x_ = ld4bf(P + (size_t)(t0 + (q_)) * PL + IW + (o_)); (f32x4){x_.x, x_.y, x_.z, x_.w} * 0.03125f; })
      A.w0 = TK4_W(2 * hl, 0); A.w1 = TK4_W(2 * hl, 4); A.w2 = TK4_W(2 * hl + 1, 0); A.w3 = TK4_W(2 * hl + 1, 4);
      A.w4 = TK4_W(4 + 2 * hl, 0); A.w5 = TK4_W(4 + 2 * hl, 4); A.w6 = TK4_W(4 + 2 * hl + 1, 0); A.w7 = TK4_W(4 + 2 * hl + 1, 4);
#undef TK4_W
    }
    const bf16_t* ikb = IKC + (size_t)b * L * 32 + 8 * hl;
    __syncthreads();
    {
      const int part = (row >> 3) & 1, Q = 4 * ((row >> 1) & 1) + 2 * ((row >> 2) & 1) + (row & 1);
      const LAS u32x4* qs = (const LAS u32x4*)(ql + (Q * 2 + part) * 32 + 8 * hl);
      A.a20 = row < 16 ? qs[0] : zero4; A.a21 = row < 16 ? qs[2] : zero4; }
    const bool sampled = (tl0 + 7) >= 1024;
    if (sampled) {
        u32x4 sb0[4], sb1[4];
#pragma unroll
        for (int jj = 0; jj < 4; ++jj) { int j = wv + 8 * jj; j = 8 * j < ntiles ? j : 0; const bf16_t* kp = ikb + (size_t)(8 * j * 32 + row) * 32; sb0[jj] = *(const u32x4*)kp; sb1[jj] = *(const u32x4*)(kp + 16); }
#pragma unroll
        for (int jj = 0; jj < 4; ++jj) {
            const int j = wv + 8 * jj;
            if (8 * j < ntiles) {
                const int tile = 8 * j, key = tile * 32 + row;
                float f[4]; TK4_SCORES(sb0[jj], sb1[jj], f);
#pragma unroll
                for (int i = 0; i < 4; ++i) { const int q = 4 * (i >> 1) + 2 * hl + (i & 1);
                    if (key <= tl0 + q) { const unsigned bin = (unsigned)(int)fminf(fmaxf((f[i] + 4.0f) * 64.0f, 0.f), 1023.f); __hip_atomic_fetch_add(&hist[q * 1024 + bin], 1u, __ATOMIC_RELAXED, __HIP_MEMORY_SCOPE_WORKGROUP); } }
            }
        }
    }
    __syncthreads();
    const unsigned char* ikbase = (const unsigned char*)(IKC + (size_t)b * L * 32);
    const unsigned ikoff = (unsigned)(row * 64 + hl * 16);
    u32x4 n1a[2], n1b[2], n2a[2], n2b[2], n3a[2], n3b[2];
#define TK4_LOADQ(A_, B_, tg_) do { _Pragma("unroll") for (int uu = 0; uu < 2; ++uu) { int tile_ = (tg_) + 8 * uu; tile_ = tile_ < ntiles ? tile_ : ntiles - 1; \
        const unsigned char* kp_ = ikbase + (ikoff + (unsigned)tile_ * 2048u); A_[uu] = *(const u32x4*)kp_; B_[uu] = *(const u32x4*)(kp_ + 32); } } while (0)
    TK4_LOADQ(n1a, n1b, wv); TK4_LOADQ(n2a, n2b, wv + 16); TK4_LOADQ(n3a, n3b, wv + 32);
    {
        const int q = wv; const int nq = tl0 + q + 1;
        float tq = -3.0e38f;
        if (nq > 1024) {
            tq = -4.0f;
            const LAS u32x4* h1 = (const LAS u32x4*)(hist + q * 1024 + 16 * lane);
            unsigned cs[16]; unsigned tot = 0u;
#pragma unroll
            for (int i = 0; i < 4; ++i) { const u32x4 v4 = h1[i]; cs[4 * i] = v4.x; cs[4 * i + 1] = v4.y; cs[4 * i + 2] = v4.z; cs[4 * i + 3] = v4.w; tot += v4.x + v4.y + v4.z + v4.w; }
            const unsigned pin = wave_incl_scan_u(tot);
            unsigned cum = rdlane_u(pin, 63) - pin; int found = -1;
#pragma unroll
            for (int i = 15; i >= 0; --i) { if (cum < (unsigned)TK4_TARGET && cum + cs[i] >= (unsigned)TK4_TARGET) found = 16 * lane + i; cum += cs[i]; }
            const unsigned long long fm = __ballot(found >= 0);
            if (fm) { const int src = __builtin_amdgcn_readfirstlane(__ffsll((long long)fm) - 1); const int fb = (int)rdlane_u((unsigned)found, src); tq = (float)fb * (1.f / 64.f) - 4.0f; }
        }
        if (lane == 0) { tau[q] = tq; todo[q] = 1u; }
    }
    __syncthreads();
    { const unsigned nb_ = 0xff800000u + zz_; const u32x4 ninf4 = (u32x4){nb_, nb_, nb_, nb_};
      for (int i = tid; i < 32768 / 16; i += 512) ((LAS u32x4*)(sm + TK5_VAL))[i] = ninf4; }
#pragma unroll 1
    for (int attempt = 0; attempt < 8; ++attempt) {
        __syncthreads();
        if (attempt > 0) {
            TK4_LOADQ(n1a, n1b, wv); TK4_LOADQ(n2a, n2b, wv + 16); TK4_LOADQ(n3a, n3b, wv + 32);
            const unsigned nb_ = 0xff800000u + zz_; const u32x4 ninf4 = (u32x4){nb_, nb_, nb_, nb_};
#pragma unroll 1
            for (int q = 0; q < 8; ++q) if (todo[q] != 0u && tid < 256) ((LAS u32x4*)(sm + TK5_VAL + q * 4096))[tid] = ninf4;
            __syncthreads();
        }
        float tq[4];
        { int hl_a = hl; asm volatile("" : "+v"(hl_a));
#pragma unroll
          for (int i = 0; i < 4; ++i) { const int q = 4 * (i >> 1) + 2 * hl_a + (i & 1); tq[i] = todo[q] != 0u ? tau[q] : __builtin_inff(); } }
        unsigned cl0 = 0u, cl1 = 0u, cl2 = 0u, cl3 = 0u;
        LAS unsigned* vbase = val + ((2 * hl * 8 + wv) * 128 + row * 4);
#define TK5_FILT1(F_, i_, CN_, key2_, key_) do { \
            if ((key2_) <= tl0 + 4 * ((i_) >> 1) + ((i_) & 1) && F_[i_] >= tq[i_]) { \
                if (CN_ < 4u) { LAS unsigned* le_ = vbase + ((4 * ((i_) >> 1) + ((i_) & 1)) * 1024) + CN_; le_[0] = __float_as_uint(F_[i_]); le_[8192] = (unsigned)(key_); } \
                else { int hl_r = hl; asm volatile("" : "+v"(hl_r));        \
                       const int q_ = 4 * ((i_) >> 1) + 2 * hl_r + ((i_) & 1); const unsigned p_ = __hip_atomic_fetch_add(&ovc[q_], 1u, __ATOMIC_RELAXED, __HIP_MEMORY_SCOPE_WORKGROUP); \
                       if (p_ < 128u) ovf[q_ * 128 + p_] = (u32x2){__float_as_uint(F_[i_]), (unsigned)(key_)}; } \
                CN_ += 1u; } } while (0)
#define TK5_FILTER(F_, TILE_) do { const int key_ = (TILE_) * 32 + row, key2_ = key_ - 2 * hl; TK5_FILT1(F_, 0, cl0, key2_, key_); TK5_FILT1(F_, 1, cl1, key2_, key_); TK5_FILT1(F_, 2, cl2, key2_, key_); TK5_FILT1(F_, 3, cl3, key2_, key_); } while (0)
#define TK5_ITER(A_, B_, TG_) do { const int tg_ = (TG_); float fA_[4], fB_[4]; TK4_SCORES(A_[0], B_[0], fA_); __builtin_amdgcn_sched_barrier(0); TK4_SCORES(A_[1], B_[1], fB_); \
            if (tg_ + 48 < ntiles) TK4_LOADQ(A_, B_, tg_ + 48); \
            TK5_FILTER(fA_, tg_); TK5_FILTER(fB_, tg_ + 8); } while (0)
#pragma unroll 1
        for (int tg = wv; tg < ntiles; tg += 48) {
            TK5_ITER(n1a, n1b, tg);
            if (tg + 16 >= ntiles) break;
            TK5_ITER(n2a, n2b, tg + 16);
            if (tg + 32 >= ntiles) break;
            TK5_ITER(n3a, n3b, tg + 32);
        }
#undef TK5_ITER
#undef TK5_FILTER
#undef TK5_FILT1
        int lane_p = lane; asm volatile("" : "+v"(lane_p));
        cl0 = half_sum32u(cl0); cl1 = half_sum32u(cl1); cl2 = half_sum32u(cl2); cl3 = half_sum32u(cl3);
        if ((lane_p & 31) == 0) {
            const int qb = 2 * (lane_p >> 5);
            if (todo[qb]) wcnt[qb * 8 + wv] = cl0; if (todo[qb + 1]) wcnt[(qb + 1) * 8 + wv] = cl1; if (todo[qb + 4]) wcnt[(qb + 4) * 8 + wv] = cl2; if (todo[qb + 5]) wcnt[(qb + 5) * 8 + wv] = cl3;
        }
        __syncthreads();
        int tid_c = tid; asm volatile("" : "+v"(tid_c));
        if (tid_c < 8) {
            const int q = tid_c; const unsigned nq = (unsigned)(tl0 + q + 1), need = nq < 256u ? nq : 256u;
            unsigned td = 0u;
            if (todo[q]) { unsigned mq = 0u;
#pragma unroll
                for (int w8 = 0; w8 < 8; ++w8) mq += wcnt[q * 8 + w8];
                cnt[q] = mq;
                if (mq < need) { tau[q] = (attempt >= 2) ? -4.0f : tau[q] - 0.25f * (float)(attempt + 1); td = 1u; }
                else if (ovc[q] > 128u) { tau[q] = tau[q] + (1.f / 64.f) * (float)(1u + (mq > 700u ? (mq - 700u) / 48u : 0u)); td = 1u; }
                if (td) ovc[q] = 0u;
            }
            todo[q] = td; if (td) todo[8] = 1u;
        }
        __syncthreads();
        const bool again = todo[8] != 0u;
        __syncthreads();
        if (tid == 0) todo[8] = 0u;
        if (!again) break;
    }
    __syncthreads();
#undef TK4_LOADQ
    if (un >= 0) tk5_prefetch(un, sm, P, tid);
    {
        int lane_o = lane; asm volatile("" : "+v"(lane_o)); const int lane = lane_o;
        const int q = wv; const unsigned nq = (unsigned)(tl0 + q + 1);
        const unsigned mq = cnt[q]; unsigned ovn = ovc[q]; ovn = ovn < 128u ? ovn : 128u;
        LAS unsigned* hq = h2 + q * 1024; LAS unsigned* mk = lmask + q * 256;
        const float NINF = -__builtin_inff();
        float v[18]; unsigned ix[18];
        { const LAS unsigned* vq = val + q * 1024 + lane;
#pragma unroll
          for (int k = 0; k < 16; ++k) { v[k] = __uint_as_float(vq[64 * k]); ix[k] = vq[64 * k + 8192]; }
#pragma unroll
          for (int k = 0; k < 2; ++k) { v[16 + k] = NINF; ix[16 + k] = 0u; if ((unsigned)(lane + 64 * k) < ovn) { const u32x2 e = ovf[q * 128 + lane + 64 * k]; v[16 + k] = __uint_as_float(e.x); ix[16 + k] = e.y; } } }
        if (mq <= 256u || nq <= 256u) {
#pragma unroll
            for (int k = 0; k < 18; ++k) if (v[k] > NINF) __hip_atomic_fetch_or(&mk[ix[k] >> 5], 1u << (ix[k] & 31u), __ATOMIC_RELAXED, __HIP_MEMORY_SCOPE_WORKGROUP);
        } else {
            float fmn = 3.0e38f, fmx = -3.0e38f;
#pragma unroll
            for (int k = 0; k < 18; ++k) { fmn = v[k] > NINF ? fminf(fmn, v[k]) : fmn; fmx = fmaxf(fmx, v[k]); }
            fmx = wave_max(fmx, lane); fmn = -wave_max(-fmn, lane);
            float lo0 = fmn, sc0 = 1023.0f / fmaxf(fmx - fmn, 1e-30f), lo1 = 0.f, sc1 = 0.f, lo2 = 0.f, sc2 = 0.f, lo3 = 0.f, sc3 = 0.f;
            unsigned bs0 = 0u, bs1 = 0u, bs2 = 0u, need = 256u;
#define TK4_B(f_, lo_, sc_) ((unsigned)(int)fminf(fmaxf(((f_) - (lo_)) * (sc_), 0.f), 1023.f))
#define TK5_ACT(f_) ((f_) > NINF && (lv < 1 || TK4_B(f_, lo0, sc0) == bs0) && (lv < 2 || TK4_B(f_, lo1, sc1) == bs1) && (lv < 3 || TK4_B(f_, lo2, sc2) == bs2))
            bool sel_done = false;
            { constexpr int lv = 0;
                const float lo = lv == 0 ? lo0 : lv == 1 ? lo1 : lv == 2 ? lo2 : lo3, sc = lv == 0 ? sc0 : lv == 1 ? sc1 : lv == 2 ? sc2 : sc3;
#pragma unroll
                for (int j = 0; j < 4; ++j) ((LAS u32x4*)hq)[4 * lane + j] = zero4;
                asm volatile("s_waitcnt lgkmcnt(0)" ::: "memory");
#pragma unroll
                for (int k = 0; k < 18; ++k) if (TK5_ACT(v[k])) __hip_atomic_fetch_add(&hq[TK4_B(v[k], lo, sc)], 1u, __ATOMIC_RELAXED, __HIP_MEMORY_SCOPE_WORKGROUP);
                asm volatile("s_waitcnt lgkmcnt(0)" ::: "memory");
                unsigned bstar = 0u, nd = 0u, pop = 0u;
                { const LAS u32x4* h1 = (const LAS u32x4*)(hq + 16 * lane);
                  unsigned cs[16]; unsigned tot = 0u;
#pragma unroll
                  for (int i = 0; i < 4; ++i) { const u32x4 v4 = h1[i]; cs[4 * i] = v4.x; cs[4 * i + 1] = v4.y; cs[4 * i + 2] = v4.z; cs[4 * i + 3] = v4.w; tot += v4.x + v4.y + v4.z + v4.w; }
                  const unsigned pin = wave_incl_scan_u(tot);
                  unsigned cum = rdlane_u(pin, 63) - pin; int fd = -1; unsigned fk = 0u, ft = 0u;
#pragma unroll
                  for (int i = 15; i >= 0; --i) { if (cum < need && cum + cs[i] >= need) { fd = 16 * lane + i; fk = need - cum; ft = cs[i]; } cum += cs[i]; }
                  const unsigned long long fm = __ballot(fd >= 0); const int src = __builtin_amdgcn_readfirstlane(__ffsll((long long)fm) - 1);
                  bstar = rdlane_u((unsigned)fd, src); nd = rdlane_u(fk, src); pop = rdlane_u(ft, src); }
                const bool fin = pop <= 64u || lv == 3;
                LAS u32x2* cl = (LAS u32x2*)(sm + TK5_CL) + q * 64; unsigned ccnt = 0u;
                {
                    unsigned cmask = 0u, mycnt = 0u;
#pragma unroll
                    for (int k = 0; k < 18; ++k) {
                        const bool act = v[k] > NINF; const unsigned bn = TK4_B(v[k], lo, sc);
                        if (act && bn > bstar) __hip_atomic_fetch_or(&mk[ix[k] >> 5], 1u << (ix[k] & 31u), __ATOMIC_RELAXED, __HIP_MEMORY_SCOPE_WORKGROUP);
                        const bool cd = fin && act && bn == bstar; cmask |= cd ? (1u << k) : 0u; mycnt += cd ? 1u : 0u;
                    }
                    const unsigned incl = wave_incl_scan_u(mycnt);
                    ccnt = rdlane_u(incl, 63);
                    unsigned off = incl - mycnt;
                    if (cmask) {
#pragma unroll
                        for (int k = 0; k < 18; ++k) if (cmask & (1u << k)) { if (off < 64u) cl[off] = (u32x2){__float_as_uint(v[k]), ix[k]}; ++off; }
                    }
                }
                if (fin) {
                    asm volatile("s_waitcnt lgkmcnt(0)" ::: "memory");
                    ccnt = ccnt < 64u ? ccnt : 64u;
                    if (lane < (int)ccnt) { const u32x2 me = cl[lane]; unsigned rk = 0u;
                        for (unsigned jj = 0; jj < ccnt; ++jj) { const u32x2 o2 = cl[jj]; const float of = __uint_as_float(o2.x), mf = __uint_as_float(me.x); rk += (of > mf || (of == mf && o2.y < me.y)) ? 1u : 0u; }
                        if (rk < nd) __hip_atomic_fetch_or(&mk[me.y >> 5], 1u << (me.y & 31u), __ATOMIC_RELAXED, __HIP_MEMORY_SCOPE_WORKGROUP); }
                    sel_done = true;
                }
                if (!sel_done) {
                const float nlo = lo + (float)bstar / sc, nsc = sc * 1024.0f;
                if (lv == 0) { bs0 = bstar; lo1 = nlo; sc1 = nsc; } else if (lv == 1) { bs1 = bstar; lo2 = nlo; sc2 = nsc; } else { bs2 = bstar; lo3 = nlo; sc3 = nsc; }
                need = nd;
                            }
            }
#pragma unroll 1
            for (int lv = 1; lv < 4 && !sel_done; ++lv) {
                const float lo = lv == 0 ? lo0 : lv == 1 ? lo1 : lv == 2 ? lo2 : lo3, sc = lv == 0 ? sc0 : lv == 1 ? sc1 : lv == 2 ? sc2 : sc3;
#pragma unroll
                for (int j = 0; j < 4; ++j) ((LAS u32x4*)hq)[4 * lane + j] = zero4;
                asm volatile("s_waitcnt lgkmcnt(0)" ::: "memory");
#pragma unroll
                for (int k = 0; k < 18; ++k) if (TK5_ACT(v[k])) __hip_atomic_fetch_add(&hq[TK4_B(v[k], lo, sc)], 1u, __ATOMIC_RELAXED, __HIP_MEMORY_SCOPE_WORKGROUP);
                asm volatile("s_waitcnt lgkmcnt(0)" ::: "memory");
                unsigned bstar = 0u, nd = 0u, pop = 0u;
                { const LAS u32x4* h1 = (const LAS u32x4*)(hq + 16 * lane);
                  unsigned cs[16]; unsigned tot = 0u;
#pragma unroll
                  for (int i = 0; i < 4; ++i) { const u32x4 v4 = h1[i]; cs[4 * i] = v4.x; cs[4 * i + 1] = v4.y; cs[4 * i + 2] = v4.z; cs[4 * i + 3] = v4.w; tot += v4.x + v4.y + v4.z + v4.w; }
                  const unsigned pin = wave_incl_scan_u(tot);
                  unsigned cum = rdlane_u(pin, 63) - pin; int fd = -1; unsigned fk = 0u, ft = 0u;
#pragma unroll
                  for (int i = 15; i >= 0; --i) { if (cum < need && cum + cs[i] >= need) { fd = 16 * lane + i; fk = need - cum; ft = cs[i]; } cum += cs[i]; }
                  const unsigned long long fm = __ballot(fd >= 0); const int src = __builtin_amdgcn_readfirstlane(__ffsll((long long)fm) - 1);
                  bstar = rdlane_u((unsigned)fd, src); nd = rdlane_u(fk, src); pop = rdlane_u(ft, src); }
                const bool fin = pop <= 64u || lv == 3;
                LAS u32x2* cl = (LAS u32x2*)(sm + TK5_CL) + q * 64; unsigned ccnt = 0u;
#pragma unroll
                for (int k = 0; k < 18; ++k) {
                    const bool act = TK5_ACT(v[k]); const unsigned bn = TK4_B(v[k], lo, sc);
                    if (act && bn > bstar) __hip_atomic_fetch_or(&mk[ix[k] >> 5], 1u << (ix[k] & 31u), __ATOMIC_RELAXED, __HIP_MEMORY_SCOPE_WORKGROUP);
                    const bool cd = fin && act && bn == bstar; const unsigned long long cm = __ballot(cd);
                    const unsigned cp = ccnt + (unsigned)__popcll(cm & ((1ull << lane) - 1ull));
                    if (cd && cp < 64u) cl[cp] = (u32x2){__float_as_uint(v[k]), ix[k]};
                    ccnt += (unsigned)__popcll(cm);
                }
                if (fin) {
                    asm volatile("s_waitcnt lgkmcnt(0)" ::: "memory");
                    ccnt = ccnt < 64u ? ccnt : 64u;
                    if (lane < (int)ccnt) { const u32x2 me = cl[lane]; unsigned rk = 0u;
                        for (unsigned jj = 0; jj < ccnt; ++jj) { const u32x2 o2 = cl[jj]; const float of = __uint_as_float(o2.x), mf = __uint_as_float(me.x); rk += (of > mf || (of == mf && o2.y < me.y)) ? 1u : 0u; }
                        if (rk < nd) __hip_atomic_fetch_or(&mk[me.y >> 5], 1u << (me.y & 31u), __ATOMIC_RELAXED, __HIP_MEMORY_SCOPE_WORKGROUP); }
                    break;
                }
                const float nlo = lo + (float)bstar / sc, nsc = sc * 1024.0f;
                if (lv == 0) { bs0 = bstar; lo1 = nlo; sc1 = nsc; } else if (lv == 1) { bs1 = bstar; lo2 = nlo; sc2 = nsc; } else { bs2 = bstar; lo3 = nlo; sc3 = nsc; }
                need = nd;
                        }
#undef TK5_ACT
#undef TK4_B
        }
    }
    __syncthreads();
    for (int i = tid; i < 8 * 128; i += 512) { const int q = i >> 7, j = i & 127; u32x2 v; v.x = lmask[q * 256 + 2 * j]; v.y = lmask[q * 256 + 2 * j + 1]; *(u32x2*)(MASK + (size_t)(t0 + q) * 128 + j) = v; }
}

__device__ __forceinline__ s16x4_t lds_tr16(const LAS unsigned char* p) { return __builtin_bit_cast(s16x4_t, __builtin_amdgcn_ds_read_tr16_b64_v4i16((LAS s16x4_t*)p)); }
__device__ __forceinline__ void dsa_issue_tile(const unsigned char* tile, unsigned koff, unsigned voff, LAS unsigned char* buf, int wave) {
#pragma unroll
    for (int i = 0; i < 4; ++i)
        __builtin_amdgcn_global_load_lds((const unsigned*)(tile + (koff + (unsigned)i * (16u * PL * 2u))), (LAS unsigned*)(buf + (512 * i + wave * 64) * 16), 16, 0, 0);
#pragma unroll
    for (int i = 0; i < 4; ++i)
        __builtin_amdgcn_global_load_lds((const unsigned*)(tile + (voff + (unsigned)i * 128u)), (LAS unsigned*)(buf + 32768 + (512 * i + wave * 64) * 16), 16, 0, 0);
}
__device__ __forceinline__ void dsa_attn_unit(int b, int qb, LAS unsigned char* lds, const bf16_t* __restrict__ PROJ, const unsigned long long* __restrict__ MASK, const float* __restrict__ ng, bf16_t* __restrict__ CAT, int tid) {
    const int wave = __builtin_amdgcn_readfirstlane(tid >> 6), lane = tid & 63, h = wave & 3, rb = wave >> 2, q = lane & 31, hl = lane >> 5;
    const size_t trow = (size_t)b * L + qb * 64 + rb * 32 + q;
    const float C2 = 0.125f * 1.4426950408889634f, NEG = -1e30f; const unsigned NEGB = __float_as_uint(NEG);
    bf16x8_t qf[4];
#pragma unroll
    for (int ds = 0; ds < 4; ++ds) {
        const u32x4 w = *(const u32x4*)(PROJ + trow * PL + DQ + h * 64 + 16 * ds + 8 * hl);
        u32x4 o;
        o.x = pk2(__uint_as_float(w.x << 16) * C2, __uint_as_float(w.x & 0xffff0000u) * C2); o.y = pk2(__uint_as_float(w.y << 16) * C2, __uint_as_float(w.y & 0xffff0000u) * C2);
        o.z = pk2(__uint_as_float(w.z << 16) * C2, __uint_as_float(w.z & 0xffff0000u) * C2); o.w = pk2(__uint_as_float(w.w << 16) * C2, __uint_as_float(w.w & 0xffff0000u) * C2);
        qf[ds] = __builtin_bit_cast(bf16x8_t, o);
    }
    f32x16_t o0, o1;
#pragma unroll
    for (int r = 0; r < 16; ++r) { o0[r] = 0.f; o1[r] = 0.f; }
    float m_ref = 0.f; f32x2_t lsum = (f32x2_t){0.f, 0.f}; bool shifted = false;
    const unsigned char* mbase = (const unsigned char*)((const unsigned*)MASK + (size_t)b * L * 256);
    const unsigned moff = (unsigned)(((qb * 64 + rb * 32 + (lane >> 1)) * 256 + (lane & 1)) * 4);
    LAS unsigned char* mbuf = lds + 132096 + wave * 512;
    const unsigned char* kv0 = (const unsigned char*)(PROJ + (size_t)b * L * PL);
    const unsigned koff = (unsigned)(((tid >> 5) * PL + DK + ((tid & 31) >> 3) * 64 + (((tid & 7) ^ ((tid >> 5) & 7)) * 8)) * 2);
    const unsigned voff = (unsigned)((((tid >> 2) & 63) * PL + DV + (tid >> 8) * 32 + (tid & 3) * 8) * 2);
    __syncthreads();
    __builtin_amdgcn_global_load_lds((const unsigned*)(mbase + moff), (LAS unsigned*)mbuf, 4, 0, 0);
    dsa_issue_tile(kv0, koff, voff, lds, wave);
    asm volatile("s_waitcnt vmcnt(0)" ::: "memory");
    __syncthreads();
    const int kro = q * 512 + h * 128;
    const int i16 = lane & 15, c0 = 16 * ((lane >> 4) & 1);
    const int vro = (h * 2) * 4096 + (4 * hl + (i16 >> 2)) * 64 + (c0 + 4 * (i16 & 3)) * 2;
    for (int j = 0; j <= qb; ++j) {
        LAS unsigned char* Kb = lds + (j & 1) * 65536; LAS unsigned char* Vb = Kb + 32768;
        if (j < qb) {
            unsigned ko_ = koff, vo_ = voff, mo_ = moff; asm volatile("" : "+v"(ko_), "+v"(vo_), "+v"(mo_));
            __builtin_amdgcn_global_load_lds((const unsigned*)(mbase + (mo_ + (unsigned)(j + 1) * 8u)), (LAS unsigned*)(mbuf + ((j + 1) & 1) * 256), 4, 0, 0);
            dsa_issue_tile(kv0 + (size_t)(j + 1) * 64 * PL * 2, ko_, vo_, lds + ((j + 1) & 1) * 65536, wave);
        }
        f32x16_t p0, p1;
#pragma unroll
        for (int r = 0; r < 16; ++r) { p0[r] = 0.f; p1[r] = 0.f; }
#pragma unroll
        for (int ds = 0; ds < 4; ++ds) {
            const int co = ((2 * ds + hl) ^ (q & 7)) * 16;
            const bf16x8_t a0 = *(const LAS bf16x8_t*)(Kb + kro + co), a1 = *(const LAS bf16x8_t*)(Kb + kro + 32 * 512 + co);
            p0 = __builtin_amdgcn_mfma_f32_32x32x16_bf16(a0, qf[ds], p0, 0, 0, 0);
            p1 = __builtin_amdgcn_mfma_f32_32x32x16_bf16(a1, qf[ds], p1, 0, 0, 0);
        }
        const u32x2 mw = *(const LAS u32x2*)(mbuf + (j & 1) * 256 + q * 8);
        const unsigned mlo = mw.x >> (4 * hl), mhi = mw.y >> (4 * hl);
        if (shifted) {
#pragma unroll
            for (int r = 0; r < 16; ++r) { p0[r] -= m_ref; p1[r] -= m_ref; }
        }
        float mx = NEG;
#pragma unroll
        for (int r = 0; r < 16; ++r) {
            const int kk = (r & 3) + 8 * (r >> 2);
            const unsigned s0 = (unsigned)__builtin_amdgcn_sbfe((int)mlo, kk, 1), s1 = (unsigned)__builtin_amdgcn_sbfe((int)mhi, kk, 1);
            p0[r] = __uint_as_float((__float_as_uint(p0[r]) & s0) | (NEGB & ~s0)); p1[r] = __uint_as_float((__float_as_uint(p1[r]) & s1) | (NEGB & ~s1));
            asm("v_max3_f32 %0, %1, %2, %3" : "=v"(mx) : "v"(mx), "v"(p0[r]), "v"(p1[r]));
        }
        { const auto sw_ = __builtin_amdgcn_permlane32_swap(__float_as_uint(mx), __float_as_uint(mx), false, false);
          const float m0_ = __uint_as_float(sw_[0]), m1_ = __uint_as_float(sw_[1]); asm("v_max_f32 %0, %1, %2" : "=v"(mx) : "v"(m0_), "v"(m1_)); }
        const bool move = mx > -1e29f && __builtin_fabsf(mx) > 40.f;
        if (__ballot(move)) {
            const float dlt = move ? mx : 0.f, alpha = __builtin_amdgcn_exp2f(-dlt);
            m_ref += dlt; lsum *= alpha; shifted = true;
#pragma unroll
            for (int r = 0; r < 16; ++r) { o0[r] *= alpha; o1[r] *= alpha; p0[r] -= dlt; p1[r] -= dlt; }
        }
#pragma unroll
        for (int r = 0; r < 16; r += 2) {
            p0[r] = __builtin_amdgcn_exp2f(p0[r]); p0[r + 1] = __builtin_amdgcn_exp2f(p0[r + 1]); p1[r] = __builtin_amdgcn_exp2f(p1[r]); p1[r + 1] = __builtin_amdgcn_exp2f(p1[r + 1]);
            lsum += (f32x2_t){p0[r], p0[r + 1]}; lsum += (f32x2_t){p1[r], p1[r + 1]};
        }
        bf16x8_t pf[4];
#pragma unroll
        for (int s = 0; s < 2; ++s) {
            u32x4 a, c;
            a.x = pk2(p0[8 * s + 0], p0[8 * s + 1]); a.y = pk2(p0[8 * s + 2], p0[8 * s + 3]); a.z = pk2(p0[8 * s + 4], p0[8 * s + 5]); a.w = pk2(p0[8 * s + 6], p0[8 * s + 7]);
            c.x = pk2(p1[8 * s + 0], p1[8 * s + 1]); c.y = pk2(p1[8 * s + 2], p1[8 * s + 3]); c.z = pk2(p1[8 * s + 4], p1[8 * s + 5]); c.w = pk2(p1[8 * s + 6], p1[8 * s + 7]);
            pf[s] = __builtin_bit_cast(bf16x8_t, a); pf[2 + s] = __builtin_bit_cast(bf16x8_t, c);
        }
#pragma unroll
        for (int s = 0; s < 4; ++s) {
            const s16x4_t l0 = lds_tr16(Vb + vro + s * 1024), h0 = lds_tr16(Vb + vro + s * 1024 + 512);
            const s16x4_t l1 = lds_tr16(Vb + vro + 4096 + s * 1024), h1 = lds_tr16(Vb + vro + 4096 + s * 1024 + 512);
            const bf16x8_t v0 = (bf16x8_t){l0[0], l0[1], l0[2], l0[3], h0[0], h0[1], h0[2], h0[3]}, v1 = (bf16x8_t){l1[0], l1[1], l1[2], l1[3], h1[0], h1[1], h1[2], h1[3]};
            o0 = __builtin_amdgcn_mfma_f32_32x32x16_bf16(v0, pf[s], o0, 0, 0, 0);
            o1 = __builtin_amdgcn_mfma_f32_32x32x16_bf16(v1, pf[s], o1, 0, 0, 0);
        }
        asm volatile("s_waitcnt vmcnt(0)" ::: "memory");
        __syncthreads();
    }
    float l_run = sum_x32(lsum.x + lsum.y);
    const float inv = 1.f / l_run;
    float ss = 0.f;
#pragma unroll
    for (int r = 0; r < 16; ++r) { o0[r] *= inv; o1[r] *= inv; ss += o0[r] * o0[r] + o1[r] * o1[r]; }
    ss = sum_x32(ss);
    LAS float* xs = (LAS float*)(lds + 131072);
    if (hl == 0) xs[(rb * 4 + h) * 32 + q] = ss;
    __syncthreads();
    const float tot = xs[(rb * 4 + 0) * 32 + q] + xs[(rb * 4 + 1) * 32 + q] + xs[(rb * 4 + 2) * 32 + q] + xs[(rb * 4 + 3) * 32 + q];
    const float rn = rsqrtf(tot * (1.f / 256.f) + 1e-6f);
    bf16_t* orow = CAT + trow * D + 384 + h * 64;
#pragma unroll
    for (int r4 = 0; r4 < 4; ++r4) {
        const int d = 8 * r4 + 4 * hl;
        const f32x4 g0 = *(const f32x4*)(ng + h * 64 + d), g1 = *(const f32x4*)(ng + h * 64 + 32 + d);
        u32x2 w0, w1;
        w0.x = pk2(o0[4 * r4 + 0] * rn * g0.x, o0[4 * r4 + 1] * rn * g0.y); w0.y = pk2(o0[4 * r4 + 2] * rn * g0.z, o0[4 * r4 + 3] * rn * g0.w);
        w1.x = pk2(o1[4 * r4 + 0] * rn * g1.x, o1[4 * r4 + 1] * rn * g1.y); w1.y = pk2(o1[4 * r4 + 2] * rn * g1.z, o1[4 * r4 + 3] * rn * g1.w);
        *(u32x2*)(orow + d) = w0; *(u32x2*)(orow + 32 + d) = w1;
    }
}


constexpr int G3_KD = 0, G3_QD = 6144, G3_KHT = 12288, G3_V = 20480, G3_S16 = 32768, G3_RR = 41984, G3_BC = 54272, G3_PART = 66816, G3_GW = 68352, G3_DEC = 71616, G3_RED = 71872, G3_END = 72704;
template <bool FULL>
__device__ __forceinline__ void gla3_unit(int unit, int tid, LAS unsigned char* sm, const bf16_t* __restrict__ P, const float* __restrict__ gw, const float* __restrict__ gb, const float* __restrict__ ng,
                                          float* __restrict__ GSUM, bf16_t* __restrict__ CAT) {
    typedef LAS float (*a49_t)[49]; typedef LAS float (*a48_t)[48];
    a49_t bc = (a49_t)(sm + G3_BC); LAS float* part = (LAS float*)(sm + G3_PART); a48_t gwl = (a48_t)(sm + G3_GW); LAS float* dec = (LAS float*)(sm + G3_DEC); LAS float* red = (LAS float*)(sm + G3_RED);
    const int seg = unit & 15, h = (unit >> 4) & 3, b = unit >> 6;
    const int wave = __builtin_amdgcn_readfirstlane(tid >> 6), lane = tid & 63, hl = lane >> 5, l31 = lane & 31, i16 = lane & 15, c0 = 16 * ((lane >> 4) & 1);
    const int eb = wave % 3, xb = wave / 3;
    const int dl = 32 * xb + l31;
    GlaRaw cur; gla_load_raw<FULL>(cur, P, b * L + (seg * 8) * 64, h, tid);
    __syncthreads();
    for (int i = tid; i < 17 * 48; i += 512) { const int r = i / 48, j = i % 48; gwl[r][j] = (r < 16) ? gw[r * 192 + h * 48 + j] : gb[h * 48 + j]; }
    for (int i = tid; i < 16 * 64; i += 512) ((LAS bf16_t*)(sm + G3_KHT))[48 * 64 + i] = 0;
    f32x16_t sacc;
#pragma unroll
    for (int r = 0; r < 16; ++r) sacc[r] = 0.f;
    float pdec = 1.f;
    if (FULL && wave < 6 && dl < 48) {
        const float* base = GSUM + (size_t)(unit - seg) * 4672;
#pragma unroll 2
        for (int sp = 0; sp < seg; ++sp) {
            const float* su = base + (size_t)sp * 4672; const float pd = su[4608 + dl];
#pragma unroll
            for (int r4 = 0; r4 < 4; ++r4) { const float4 s4 = *(const float4*)(su + dl * 96 + 32 * eb + 8 * r4 + 4 * hl);
                sacc[4 * r4] = pd * sacc[4 * r4] + s4.x; sacc[4 * r4 + 1] = pd * sacc[4 * r4 + 1] + s4.y; sacc[4 * r4 + 2] = pd * sacc[4 * r4 + 2] + s4.z; sacc[4 * r4 + 3] = pd * sacc[4 * r4 + 3] + s4.w; }
        }
    }
    if (FULL && wave < 6) {
        if (dl < 48) {
#pragma unroll
            for (int r4 = 0; r4 < 4; ++r4) { u32x2 w; w.x = pk2(sacc[4 * r4], sacc[4 * r4 + 1]); w.y = pk2(sacc[4 * r4 + 2], sacc[4 * r4 + 3]);
                *(LAS u32x2*)(sm + G3_S16 + dl * 192 + (32 * eb + 8 * r4 + 4 * hl) * 2) = w; } }
    }
    for (int c = 0; c < 8; ++c) {
        const int t0 = b * L + (seg * 8 + c) * 64;
        GlaRaw nxt = cur;
        if (c < 7) gla_load_raw<FULL>(nxt, P, t0 + 64, h, tid);
        int tidc = tid; asm volatile("" : "+v"(tidc));
        const int rt = tidc >> 3, jg = tidc & 7;
        __syncthreads();
        {
            const int wv_ = __builtin_amdgcn_readfirstlane(tidc >> 6), tl_ = tidc & 63;
            const unsigned lw[8] = {cur.l0.x, cur.l0.y, cur.l0.z, cur.l0.w, cur.l1.x, cur.l1.y, cur.l1.z, cur.l1.w};
            float a[6];
#pragma unroll
            for (int i = 0; i < 6; ++i) a[i] = gwl[16][6 * wv_ + i];
#pragma unroll
            for (int r = 0; r < 8; ++r) { const float x0 = __uint_as_float(lw[r] << 16), x1 = __uint_as_float(lw[r] & 0xffff0000u);
#pragma unroll
                for (int i = 0; i < 6; ++i) a[i] += x0 * gwl[2 * r][6 * wv_ + i] + x1 * gwl[2 * r + 1][6 * wv_ + i]; }
#pragma unroll
            for (int i = 0; i < 6; ++i) bc[tl_][6 * wv_ + i] = wave_incl_scan_f(log_sigmoid_fast(a[i]) * (1.f / 16.f));
        }
        __syncthreads();
        {
            float kd[6], qd[6];
#pragma unroll
            for (int i = 0; i < 6; ++i) {
                const int j = 6 * jg + i; const float bcv = bc[rt][j], bl = bc[63][j];
                const unsigned kw = (i >> 1) == 0 ? cur.k.x : (i >> 1) == 1 ? cur.k.y : cur.k.z; const float kv = (i & 1) ? __uint_as_float(kw & 0xffff0000u) : __uint_as_float(kw << 16);
                ((LAS bf16_t*)(sm + G3_KHT))[j * 64 + rt] = (bf16_t)f2bf(kv * fexp(bl - bcv));
                kd[i] = kv * fexp(-bcv);
                if (FULL) { const unsigned qw = (i >> 1) == 0 ? cur.q.x : (i >> 1) == 1 ? cur.q.y : cur.q.z; const float qv = (i & 1) ? __uint_as_float(qw & 0xffff0000u) : __uint_as_float(qw << 16);
                    qd[i] = qv * 0.14433756729740643f * fexp(bcv); }
            }
            if (FULL) {
#pragma unroll
                for (int i = 0; i < 3; ++i) { *(LAS unsigned*)(sm + G3_KD + rt * 96 + (6 * jg + 2 * i) * 2) = pk2(kd[2 * i], kd[2 * i + 1]); *(LAS unsigned*)(sm + G3_QD + rt * 96 + (6 * jg + 2 * i) * 2) = pk2(qd[2 * i], qd[2 * i + 1]); }
            }
            *(LAS u32x2*)(sm + G3_V + rt * 192 + (12 * jg) * 2) = cur.v0; *(LAS u32x2*)(sm + G3_V + rt * 192 + (12 * jg + 4) * 2) = cur.v1; *(LAS u32x2*)(sm + G3_V + rt * 192 + (12 * jg + 8) * 2) = cur.v2;
            if (FULL) { *(LAS u32x2*)(sm + G3_RR + rt * 192 + (12 * jg) * 2) = cur.r0; *(LAS u32x2*)(sm + G3_RR + rt * 192 + (12 * jg + 4) * 2) = cur.r1; *(LAS u32x2*)(sm + G3_RR + rt * 192 + (12 * jg + 8) * 2) = cur.r2; }
            if (tidc < 48) dec[tidc] = fexp(bc[63][tidc]);
        }
        __syncthreads();
        const int vro = (4 * hl + (i16 >> 2)) * 192 + (32 * eb + c0 + 4 * (i16 & 3)) * 2;
        if (FULL) {
            f32x16_t oacc;
#pragma unroll
            for (int r = 0; r < 16; ++r) oacc[r] = 0.f;
            if (wave < 6) {
#pragma unroll
                for (int sb = 0; sb < 2; ++sb) {
                    if (sb <= xb) {
                        f32x16_t at;
#pragma unroll
                        for (int r = 0; r < 16; ++r) at[r] = 0.f;
#pragma unroll
                        for (int ks = 0; ks < 3; ++ks) {
                            const bf16x8_t ka = *(const LAS bf16x8_t*)(sm + G3_KD + (32 * sb + l31) * 96 + (16 * ks + 8 * hl) * 2);
                            const bf16x8_t qb = *(const LAS bf16x8_t*)(sm + G3_QD + (32 * xb + l31) * 96 + (16 * ks + 8 * hl) * 2);
                            at = __builtin_amdgcn_mfma_f32_32x32x16_bf16(ka, qb, at, 0, 0, 0);
                        }
                        if (sb == xb) {
#pragma unroll
                            for (int r = 0; r < 16; ++r) { const int sl = (r & 3) + 8 * (r >> 2) + 4 * hl; at[r] = (sl <= l31) ? at[r] : 0.f; }
                        }
#pragma unroll
                        for (int s2 = 0; s2 < 2; ++s2) {
                            u32x4 pw; pw.x = pk2(at[8 * s2], at[8 * s2 + 1]); pw.y = pk2(at[8 * s2 + 2], at[8 * s2 + 3]); pw.z = pk2(at[8 * s2 + 4], at[8 * s2 + 5]); pw.w = pk2(at[8 * s2 + 6], at[8 * s2 + 7]);
                            const LAS unsigned char* vp = sm + G3_V + vro + (2 * sb + s2) * 3072;
                            const s16x4_t lo = lds_tr16(vp), hi = lds_tr16(vp + 1536);
                            const bf16x8_t va = (bf16x8_t){lo[0], lo[1], lo[2], lo[3], hi[0], hi[1], hi[2], hi[3]};
                            oacc = __builtin_amdgcn_mfma_f32_32x32x16_bf16(va, __builtin_bit_cast(bf16x8_t, pw), oacc, 0, 0, 0);
                        }
                    }
                }
#pragma unroll
                for (int ks = 0; ks < 3; ++ks) {
                    const LAS unsigned char* sp = sm + G3_S16 + vro + ks * 3072;
                    const s16x4_t lo = lds_tr16(sp), hi = lds_tr16(sp + 1536);
                    const bf16x8_t sa = (bf16x8_t){lo[0], lo[1], lo[2], lo[3], hi[0], hi[1], hi[2], hi[3]};
                    const u32x2 q0 = *(const LAS u32x2*)(sm + G3_QD + (32 * xb + l31) * 96 + (16 * ks + 4 * hl) * 2), q1 = *(const LAS u32x2*)(sm + G3_QD + (32 * xb + l31) * 96 + (16 * ks + 8 + 4 * hl) * 2);
                    const u32x4 qw = (u32x4){q0.x, q0.y, q1.x, q1.y};
                    oacc = __builtin_amdgcn_mfma_f32_32x32x16_bf16(sa, __builtin_bit_cast(bf16x8_t, qw), oacc, 0, 0, 0);
                }
                float ss = 0.f;
#pragma unroll
                for (int r = 0; r < 16; ++r) ss += oacc[r] * oacc[r];
                ss = sum_x32(ss);
                if (hl == 0) red[(xb * 3 + eb) * 32 + l31] = ss;
            }
            __syncthreads();
            if (wave < 6) {
                const float tot = red[(xb * 3 + 0) * 32 + l31] + red[(xb * 3 + 1) * 32 + l31] + red[(xb * 3 + 2) * 32 + l31];
                const float rn = rsqrtf(tot * (1.f / 96.f) + 1e-6f);
                const int t = 32 * xb + l31;
#pragma unroll
                for (int r4 = 0; r4 < 4; ++r4) {
                    const int e0 = 32 * eb + 8 * r4 + 4 * hl;
                    const f32x4 g4 = *(const f32x4*)(ng + e0);
                    const u32x2 rw = *(const LAS u32x2*)(sm + G3_RR + t * 192 + e0 * 2);
                    const float r0 = __uint_as_float(rw.x << 16), r1 = __uint_as_float(rw.x & 0xffff0000u), r2 = __uint_as_float(rw.y << 16), r3 = __uint_as_float(rw.y & 0xffff0000u);
                    u32x2 w; w.x = pk2(oacc[4 * r4] * rn * g4.x * siluf(r0), oacc[4 * r4 + 1] * rn * g4.y * siluf(r1)); w.y = pk2(oacc[4 * r4 + 2] * rn * g4.z * siluf(r2), oacc[4 * r4 + 3] * rn * g4.w * siluf(r3));
                    *(u32x2*)(CAT + (size_t)(t0 + t) * D + h * 96 + e0) = w;
                }
            }
        }
        if (wave < 6) {
            const float dd = dec[dl < 48 ? dl : 0];
            pdec *= dd;
#pragma unroll
            for (int r = 0; r < 16; ++r) sacc[r] *= dd;
#pragma unroll
            for (int ks = 0; ks < 4; ++ks) {
                const LAS unsigned char* vp = sm + G3_V + vro + ks * 3072;
                const s16x4_t lo = lds_tr16(vp), hi = lds_tr16(vp + 1536);
                const bf16x8_t va = (bf16x8_t){lo[0], lo[1], lo[2], lo[3], hi[0], hi[1], hi[2], hi[3]};
                const u32x2 k0 = *(const LAS u32x2*)(sm + G3_KHT + dl * 128 + (16 * ks + 4 * hl) * 2), k1 = *(const LAS u32x2*)(sm + G3_KHT + dl * 128 + (16 * ks + 8 + 4 * hl) * 2);
                const u32x4 kw = (u32x4){k0.x, k0.y, k1.x, k1.y};
                sacc = __builtin_amdgcn_mfma_f32_32x32x16_bf16(va, __builtin_bit_cast(bf16x8_t, kw), sacc, 0, 0, 0);
            }
        }
        if (FULL) {
            __syncthreads();
            if (wave < 6 && dl < 48) {
#pragma unroll
                for (int r4 = 0; r4 < 4; ++r4) { u32x2 w; w.x = pk2(sacc[4 * r4], sacc[4 * r4 + 1]); w.y = pk2(sacc[4 * r4 + 2], sacc[4 * r4 + 3]);
                    *(LAS u32x2*)(sm + G3_S16 + dl * 192 + (32 * eb + 8 * r4 + 4 * hl) * 2) = w; } }
        }
        cur = nxt;
    }
    if (!FULL && wave < 6 && dl < 48) {
        float* su = GSUM + (size_t)unit * 4672;
#pragma unroll
        for (int r4 = 0; r4 < 4; ++r4) *(float4*)(su + dl * 96 + 32 * eb + 8 * r4 + 4 * hl) = make_float4(sacc[4 * r4], sacc[4 * r4 + 1], sacc[4 * r4 + 2], sacc[4 * r4 + 3]);
        if (eb == 0 && hl == 0) su[4608 + dl] = pdec;
    }
}

__device__ __forceinline__ void ph_norm2_router(LAS unsigned char* lds, const float* __restrict__ X, const float* __restrict__ g, const float* __restrict__ modl, const float* __restrict__ wg, const float* __restrict__ bg,
                                                const float* __restrict__ we, const float* __restrict__ be, bf16_t* __restrict__ HN, unsigned* __restrict__ cnt, int* __restrict__ TOKE, int* __restrict__ EID, float* __restrict__ EW, int* __restrict__ SLOT,
                                                const int tid, const int bx, const int G) {
    LAS float* Wt = (LAS float*)lds;
    LAS float* lgs = (LAS float*)(lds + 36 * 1024 * 4);
    LAS unsigned* lcnt = (LAS unsigned*)(lgs + 8 * 80);
    const int wave = tid >> 6, lane = tid & 63;
    __syncthreads();
    if (tid < 64) lcnt[tid] = 0u;
#pragma unroll
    for (int i = tid; i < 1024 * 8; i += 512) { const int k = i & 1023, e4 = (i >> 10) * 4; const float4 w4 = *(const float4*)(we + k * 32 + e4);
        Wt[(4 + e4) * 1024 + k] = w4.x; Wt[(5 + e4) * 1024 + k] = w4.y; Wt[(6 + e4) * 1024 + k] = w4.z; Wt[(7 + e4) * 1024 + k] = w4.w; }
#pragma unroll
    for (int k = tid; k < 1024; k += 512) { const float4 w4 = *(const float4*)(wg + k * 4); Wt[k] = w4.x; Wt[1024 + k] = w4.y; Wt[2048 + k] = w4.z; Wt[3072 + k] = w4.w; }
    __syncthreads();
    LAS float* lg = lgs + wave * 80;
    int ridx[2]; bool rok[2];
#pragma unroll
    for (int i = 0; i < 2; ++i) {
        int x = i + 2 * (lane & 1); bool ok = x < 3;
        x += 3 * ((lane >> 1) & 1); ok = ok && x < 5;
        x += 5 * ((lane >> 2) & 1); ok = ok && x < 9;
        x += 9 * ((lane >> 3) & 1); x += 18 * ((lane >> 4) & 1); x += 36 * ((lane >> 5) & 1);
        ridx[i] = (x / 36) * 40 + (x % 36); rok[i] = ok;
    }
    float bias2[2];
#pragma unroll
    for (int i = 0; i < 2; ++i) { const int j = ridx[i] % 40; bias2[i] = rok[i] ? (j < 4 ? bg[j] : be[j - 4]) : 0.f; }
    for (int t0 = (bx * NWAVES + wave) * 2; t0 < T; t0 += G * NWAVES * 2) {
        const int b = t0 / L;
        f32x4 hv[2][4];
#pragma unroll
        for (int q = 0; q < 2; ++q) {
            const float* xr = X + (size_t)(t0 + q) * D;
#pragma unroll
            for (int i = 0; i < 4; ++i) hv[q][i] = *(const f32x4*)(xr + 4 * lane + 256 * i);
        }
        f32x4 gg[4], sc[4], sh[4];
#pragma unroll
        for (int i = 0; i < 4; ++i) { const int col = 4 * lane + 256 * i; gg[i] = *(const f32x4*)(g + col); sc[i] = *(const f32x4*)(modl + b * 6144 + 4096 + col); sh[i] = *(const f32x4*)(modl + b * 6144 + 3072 + col); }
#pragma unroll
        for (int q = 0; q < 2; ++q) {
            float ss = 0.f;
#pragma unroll
            for (int i = 0; i < 4; ++i) ss += hv[q][i].x * hv[q][i].x + hv[q][i].y * hv[q][i].y + hv[q][i].z * hv[q][i].z + hv[q][i].w * hv[q][i].w;
            ss = wave_sum(ss, lane);
            const float r = rsqrtf(ss * (1.f / D) + 1e-6f);
#pragma unroll
            for (int i = 0; i < 4; ++i) { const int col = 4 * lane + 256 * i;
                hv[q][i] = hv[q][i] * r * gg[i] * (sc[i] + 1.f) + sh[i];
                u32x2 o; o.x = pk2(hv[q][i].x, hv[q][i].y); o.y = pk2(hv[q][i].z, hv[q][i].w);
                *(u32x2*)(HN + (size_t)(t0 + q) * D + col) = o; }
        }
        float v[72];
#pragma unroll
        for (int j = 0; j < 36; ++j) {
            float a0 = 0.f, a1 = 0.f;
#pragma unroll
            for (int i = 0; i < 4; ++i) { const f32x4 w4 = *(const LAS f32x4*)(Wt + j * 1024 + 4 * lane + 256 * i);
                a0 += hv[0][i].x * w4.x + hv[0][i].y * w4.y + hv[0][i].z * w4.z + hv[0][i].w * w4.w;
                a1 += hv[1][i].x * w4.x + hv[1][i].y * w4.y + hv[1][i].z * w4.z + hv[1][i].w * w4.w; }
            v[j] = a0; v[36 + j] = a1;
        }
#define RSTEP(N_, H_, BIT_) do { const bool up_ = (lane & (BIT_)) != 0; _Pragma("unroll") for (int i = 0; i < (H_); ++i) { const float lo_ = v[i], hi_ = (i + (H_) < (N_)) ? v[i + (H_)] : 0.f; \
            const float keep_ = up_ ? hi_ : lo_, send_ = up_ ? lo_ : hi_; v[i] = keep_ + shx(send_, (BIT_), lane); } } while (0)
        RSTEP(72, 36, 32); RSTEP(36, 18, 16); RSTEP(18, 9, 8); RSTEP(9, 5, 4); RSTEP(5, 3, 2); RSTEP(3, 2, 1);
#undef RSTEP
        if (rok[0]) lg[ridx[0]] = v[0] + bias2[0];
        if (rok[1]) lg[ridx[1]] = v[1] + bias2[1];
        asm volatile("s_waitcnt lgkmcnt(0)" ::: "memory");
        if (lane < 2) {
            const LAS float* lq = lg + 40 * lane; const int t = t0 + lane;
            float gm = lq[0]; int gi = 0;
            for (int q = 1; q < 4; ++q) if (lq[q] > gm) { gm = lq[q]; gi = q; }
            float gs = 0.f; for (int q = 0; q < 4; ++q) gs += fexp(lq[q] - gm);
            const float gp = 1.f / gs;
            const LAS float* le = lq + 4 + gi * 8;
            int j1 = 0; float l1 = le[0];
            for (int j = 1; j < 8; ++j) if (le[j] > l1) { l1 = le[j]; j1 = j; }
            int j2 = -1; float l2 = -INFINITY;
            for (int j = 0; j < 8; ++j) if (j != j1 && le[j] > l2) { l2 = le[j]; j2 = j; }
            const float e2 = fexp(l2 - l1), den = 1.f + e2;
            const int ea = gi * 8 + j1, eb = gi * 8 + j2;
            EID[2 * t] = ea; EID[2 * t + 1] = eb;
            EW[2 * t] = gp / den; EW[2 * t + 1] = gp * e2 / den;
            SLOT[2 * t] = (int)__hip_atomic_fetch_add(&lcnt[ea], 1u, __ATOMIC_RELAXED, __HIP_MEMORY_SCOPE_WORKGROUP); SLOT[2 * t + 1] = (int)__hip_atomic_fetch_add(&lcnt[eb], 1u, __ATOMIC_RELAXED, __HIP_MEMORY_SCOPE_WORKGROUP);
        }
        asm volatile("s_waitcnt lgkmcnt(0)" ::: "memory");
    }
    asm volatile("s_waitcnt vmcnt(0)" ::: "memory");
    __syncthreads();
    if (tid < NE) lcnt[32 + tid] = atomicAdd(&cnt[64 * tid], lcnt[tid]);
    __syncthreads();
    for (int t0 = (bx * NWAVES + wave) * 2; t0 < T; t0 += G * NWAVES * 2)
        if (lane < 4) { const int i = 2 * t0 + lane; const int e = EID[i], s = SLOT[i] + (int)lcnt[32 + e]; SLOT[i] = s; TOKE[e * 65536 + s] = i >> 1; }
}
template <bool FINAL>
__device__ __forceinline__ void ph_moe_combine(const LAS unsigned* pl, float* __restrict__ X, const bf16_t* __restrict__ OUTR, const int* __restrict__ EID, const int* __restrict__ SLOT, const float* __restrict__ EW, const float* __restrict__ modl,
                                               const float* __restrict__ g, const float* __restrict__ modn, bf16_t* __restrict__ HN, const int tid, const int bx, const int G) {
    const int wave = tid >> 6, lane = tid & 63;
    const int st = G * NWAVES;
    int t = bx * NWAVES + wave;
    int p0n = 0, p1n = 0; float w0n = 0.f, w1n = 0.f;
    u32x2 an0, an1, an2, an3, cn0, cn1, cn2, cn3; f32x4 xn0, xn1, xn2, xn3; float w0c = 0.f, w1c = 0.f;
    an0 = an1 = an2 = an3 = cn0 = cn1 = cn2 = cn3 = (u32x2){0u, 0u}; xn0 = xn1 = xn2 = xn3 = (f32x4){0.f, 0.f, 0.f, 0.f};
#define CMB_ROWS(tt_, q0_, q1_) do { const bf16_t* o0_ = OUTR + (size_t)(q0_) * 1024 + 4 * lane; const bf16_t* o1_ = OUTR + (size_t)(q1_) * 1024 + 4 * lane; const float* xr_ = X + (size_t)(tt_) * D + 4 * lane; \
        an0 = __builtin_nontemporal_load((const u32x2*)(o0_)); an1 = __builtin_nontemporal_load((const u32x2*)(o0_ + 256)); an2 = __builtin_nontemporal_load((const u32x2*)(o0_ + 512)); an3 = __builtin_nontemporal_load((const u32x2*)(o0_ + 768)); \
        cn0 = __builtin_nontemporal_load((const u32x2*)(o1_)); cn1 = __builtin_nontemporal_load((const u32x2*)(o1_ + 256)); cn2 = __builtin_nontemporal_load((const u32x2*)(o1_ + 512)); cn3 = __builtin_nontemporal_load((const u32x2*)(o1_ + 768)); \
        xn0 = *(const f32x4*)(xr_); xn1 = *(const f32x4*)(xr_ + 256); xn2 = *(const f32x4*)(xr_ + 512); xn3 = *(const f32x4*)(xr_ + 768); } while (0)
#define CMB_POS(i_) ((int)pl[EID[(i_)]] * 256 + SLOT[(i_)])
    if (t < T) { const int q0 = CMB_POS(2 * t), q1 = CMB_POS(2 * t + 1); w0c = EW[2 * t]; w1c = EW[2 * t + 1]; CMB_ROWS(t, q0, q1); }
    if (t + st < T) { p0n = CMB_POS(2 * (t + st)); p1n = CMB_POS(2 * (t + st) + 1); w0n = EW[2 * (t + st)]; w1n = EW[2 * (t + st) + 1]; }
    for (; t < T; t += st) {
        const int b = t / L;
        const float w0 = w0c, w1 = w1c;
        const u32x2 av[4] = {an0, an1, an2, an3}, cv[4] = {cn0, cn1, cn2, cn3};
        f32x4 xv[4] = {xn0, xn1, xn2, xn3};
        float* xr = X + (size_t)t * D;
        if (t + st < T) { w0c = w0n; w1c = w1n; CMB_ROWS(t + st, p0n, p1n); }
        if (t + 2 * st < T) { p0n = CMB_POS(2 * (t + 2 * st)); p1n = CMB_POS(2 * (t + 2 * st) + 1); w0n = EW[2 * (t + 2 * st)]; w1n = EW[2 * (t + 2 * st) + 1]; }
        float ss = 0.f;
#pragma unroll
        for (int i = 0; i < 4; ++i) {
            const int col = 4 * lane + 256 * i;
            const float4 a = (float4){__uint_as_float(av[i].x << 16), __uint_as_float(av[i].x & 0xffff0000u), __uint_as_float(av[i].y << 16), __uint_as_float(av[i].y & 0xffff0000u)};
            const float4 c = (float4){__uint_as_float(cv[i].x << 16), __uint_as_float(cv[i].x & 0xffff0000u), __uint_as_float(cv[i].y << 16), __uint_as_float(cv[i].y & 0xffff0000u)};
            const f32x4 g4 = *(const f32x4*)(modl + b * 6144 + 5120 + col);
            xv[i].x += g4.x * (w0 * a.x + w1 * c.x); xv[i].y += g4.y * (w0 * a.y + w1 * c.y); xv[i].z += g4.z * (w0 * a.z + w1 * c.z); xv[i].w += g4.w * (w0 * a.w + w1 * c.w);
            ss += xv[i].x * xv[i].x + xv[i].y * xv[i].y + xv[i].z * xv[i].z + xv[i].w * xv[i].w;
        }
        ss = wave_sum(ss, lane);
        const float r = rsqrtf(ss * (1.f / D) + 1e-6f);
#pragma unroll
        for (int i = 0; i < 4; ++i) {
            const int col = 4 * lane + 256 * i;
            const f32x4 gg = *(const f32x4*)(g + col);
            if (FINAL) { __builtin_nontemporal_store(xv[i] * r * gg, (f32x4*)(xr + col)); }
            else {
                *(f32x4*)(xr + col) = xv[i];
                const f32x4 sc = *(const f32x4*)(modn + b * 6144 + 1024 + col), sh = *(const f32x4*)(modn + b * 6144 + col);
                const f32x4 y = xv[i] * r * gg * (sc + 1.f) + sh;
                u32x2 o; o.x = pk2(y.x, y.y); o.y = pk2(y.z, y.w);
                *(u32x2*)(HN + (size_t)t * D + col) = o;
            }
        }
    }
}

#undef CMB_ROWS
#undef CMB_POS
#define XB_TMO      128
#define XB_XCNT(j)  (256  + 64 * (j))
#define XB_XSUB(j)  (1280 + 64 * (j))
#define XB_XGEN(j)  (2304 + 64 * (j))
#define XB_TOP      3328
#define XB_TOPGEN   3392
#define XCD_BAR_WORDS 3456
#define XB_SPIN_CAP (1u << 18)

__device__ __forceinline__ unsigned xb_ld(unsigned* p)              { return __hip_atomic_load(p, __ATOMIC_RELAXED, __HIP_MEMORY_SCOPE_AGENT); }
__device__ __forceinline__ unsigned xb_add(unsigned* p, unsigned v) { return __hip_atomic_fetch_add(p, v, __ATOMIC_RELAXED, __HIP_MEMORY_SCOPE_AGENT); }
__device__ __forceinline__ unsigned xb_xcc_id() { return (unsigned)__builtin_amdgcn_s_getreg((3 << 11) | 20) & 0xFu; }
#define XB_SPIN(cond, bar) do { unsigned _sp = 0; while (cond) { __builtin_amdgcn_s_sleep(1); \
    if ((++_sp & 255u) == 0u) { if (xb_ld(&(bar)[XB_TMO])) break; if (_sp > XB_SPIN_CAP) { atomicAdd(&(bar)[XB_TMO], 1u); break; } } } } while (0)

struct XcdBarrier {
    unsigned* bar; unsigned x;
    volatile LAS unsigned* st;
};

__device__ __forceinline__ XcdBarrier xcd_barrier_post(unsigned* bar, volatile LAS unsigned* st, const int tid) {
    XcdBarrier b; b.bar = bar; b.x = xb_xcc_id(); b.st = st;
    if (tid == 0) (void)xb_add(&bar[XB_XCNT(b.x)], 1u);
    return b;
}
__device__ __forceinline__ void xcd_barrier_complete(unsigned* bar, unsigned x, unsigned& nloc, unsigned& nx) {
    const unsigned G = gridDim.x * gridDim.y * gridDim.z;
    unsigned sum, cnt, mine, sp = 0u;
    for (;;) {
        sum = 0u; cnt = 0u; mine = 0u;
#pragma unroll
        for (unsigned j = 0; j < 16; ++j) { const unsigned c = xb_ld(&bar[XB_XCNT(j)]); sum += c; cnt += (c > 0u) ? 1u : 0u; mine = (j == x) ? c : mine; }
        if (sum == G) break;
        __builtin_amdgcn_s_sleep(1);
        if ((++sp & 255u) == 0u) { if (xb_ld(&bar[XB_TMO])) break; if (sp > XB_SPIN_CAP) { atomicAdd(&bar[XB_TMO], 1u); break; } }
    }
    nloc = mine > 0u ? mine : 1u; nx = cnt > 0u ? cnt : 1u;
}

__device__ __forceinline__ void xcd_barrier(const XcdBarrier& b, const int tid) {
    asm volatile("s_waitcnt vmcnt(0)" ::: "memory");
    __syncthreads();
    if (tid == 0) {
        unsigned* bar = b.bar;
        __builtin_amdgcn_s_waitcnt(0);
        unsigned nloc = b.st[0], nx = b.st[1];
        if (nloc == 0u) { xcd_barrier_complete(bar, b.x, nloc, nx); b.st[0] = nloc; b.st[1] = nx; }
        const unsigned old = xb_add(&bar[XB_XSUB(b.x)], 1u);
        const unsigned gen = old / nloc;
        if (old + 1u == (gen + 1u) * nloc) {
            __builtin_amdgcn_fence(__ATOMIC_RELEASE, "agent");
            asm volatile("s_waitcnt vmcnt(0)" ::: "memory");
            const unsigned og = xb_add(&bar[XB_TOP], 1u);
            const unsigned tg = og / nx;
            if (og + 1u == (tg + 1u) * nx) xb_add(&bar[XB_TOPGEN], 1u);
            else XB_SPIN(xb_ld(&bar[XB_TOPGEN]) == tg, bar);
            __builtin_amdgcn_fence(__ATOMIC_ACQUIRE, "agent");
            xb_add(&bar[XB_XGEN(b.x)], 1u);
            asm volatile("s_waitcnt vmcnt(0)" ::: "memory");
        } else {
            XB_SPIN(xb_ld(&bar[XB_XGEN(b.x)]) == gen, bar);
            __builtin_amdgcn_fence(__ATOMIC_ACQUIRE, "agent");
            asm volatile("s_waitcnt vmcnt(0)" ::: "memory");
        }
    }
    __syncthreads();
}

constexpr int LDS_BYTES = 160 * 1024;
__global__ void __launch_bounds__(512, 2) k_mega(Params p) {
    extern __shared__ __attribute__((aligned(16))) unsigned char lds_raw[];
    LAS unsigned char* lds = (LAS unsigned char*)lds_raw;
    cg::grid_group grid = cg::this_grid();
    if (threadIdx.x < 2) ((volatile LAS unsigned*)(lds + 163832))[threadIdx.x] = 0u;
    __syncthreads();
    asm volatile("s_nop 0");
    const int wave_s = __builtin_amdgcn_readfirstlane((int)threadIdx.x >> 6);
#define PH int tid, bx = (int)blockIdx.x, G = (int)gridDim.x; asm volatile("v_mbcnt_lo_u32_b32 %0, -1, 0\n\tv_mbcnt_hi_u32_b32 %0, -1, %0\n\tv_lshl_add_u32 %0, %3, 6, %0" : "=&v"(tid), "+s"(bx), "+s"(G) : "s"(wave_s)); const int wave = tid >> 6, lane = tid & 63, half = tid >> 8, htid = tid & 255; (void)wave; (void)lane; (void)half; (void)htid;
    const unsigned long long kbase = (unsigned long long)__builtin_amdgcn_kernarg_segment_ptr();
#define KPTR(off) ({ unsigned long long r_; asm volatile("s_load_dwordx2 %0, %1, %2\n\ts_waitcnt lgkmcnt(0)" : "=s"(r_) : "s"(kbase), "i"(off) : "memory"); r_; })
#define KGAS __attribute__((address_space(1)))
#define KIN(i) ((const float*)(const KGAS float*)KPTR(8 * (i)))
#define KOUT ((float*)(KGAS float*)KPTR(248))
#define KWS ((unsigned char*)(KGAS unsigned char*)KPTR(256))
#define GSYNC() do { asm volatile("; === GSYNC %0" :: "i"(__LINE__)); { PH XcdBarrier xb_; xb_.bar = (unsigned*)(KWS + OFF_CTL); xb_.x = xb_xcc_id(); xb_.st = (volatile LAS unsigned*)(lds + 163832); xcd_barrier(xb_, tid); } } while (0)

    { PH (void)xcd_barrier_post((unsigned*)(KWS + OFF_CTL), (volatile LAS unsigned*)(lds + 163832), tid); }
#pragma clang loop unroll(disable)
    for (int l = 0; l < 2; ++l) {
        if (l == 0) {
            { PH ProArgs pa; pa.c = KIN(1); pa.ada_w = KIN(2); pa.ada_b = KIN(3); pa.w_in = KIN(5); pa.w_out = KIN(21); pa.glu_w = KIN(18); pa.s5are = KIN(10); pa.s5aim = KIN(11); pa.s5lst = KIN(12);
              pa.wgate = KIN(27); pa.wup = KIN(28); pa.wdown = KIN(29); pa.ws = KWS; pa.do_small = 1; pa.pad = 0;
              ph_prologue(pa, lds, tid, bx, G);
              if (bx == 0) for (int i = tid; i < 2048; i += 512) ((unsigned*)(pa.ws + OFF_CNT))[i] = 0u; }
            grid.sync();
            { PH unsigned char* ws = KWS;
              ph_norm1(KIN(0), KIN(4), (const float*)(ws + OFF_MOD), (bf16_t*)(ws + OFF_HN), tid, bx, G); }
            GSYNC();
        }
        { PH unsigned char* ws = KWS;
          if (l == 1 && bx == 0) for (int i = tid; i < 2048; i += 512) ((unsigned*)(ws + OFF_CNT))[i] = 0u;
          pg8::Gemm g; g.A = (bf16_t*)(ws + OFF_HN); g.Bt = (bf16_t*)(ws + OFF_W + W_WIN) + (size_t)l * PL * D; g.M = T; g.N = 2560; g.K = D; pg8::StaticOrder S; S.init(T, 2560, G, bx);
          EpiProj E; E.O = (bf16_t*)(ws + OFF_C); E.IKC = (bf16_t*)(ws + OFF_E + E_IKC);
          pg8::gemm_phase<EpiProj, pg8::StaticOrder, true, true>(lds, g, S, E, tid); }
        GSYNC();
        { PH unsigned char* ws = KWS; const bf16_t* PROJ = (const bf16_t*)(ws + OFF_C);
          const float* gw = KIN(6) + l * 16 * 192; const float* gb = KIN(7) + l * 192;
          float* GSUM = (float*)(ws + OFF_E + E_UPD);
          for (int u = bx; u < 256; u += G) gla3_unit<false>(u, tid, lds, PROJ, gw, gb, nullptr, GSUM, nullptr);
          const float *are = (const float*)(ws + OFF_TOK) + (size_t)l * 1536 * 4, *aim = nullptr, *lst = nullptr,        *bre = KIN(13) + l * 24576, *bim = KIN(14) + l * 24576;
          float* S5E = (float*)(ws + OFF_E + E_S5E);
          for (int u = bx; u < 256; u += G) s5_unit<false>(u, tid, lds, PROJ, are, aim, lst, bre, bim, nullptr, nullptr, nullptr, S5E, nullptr, nullptr, nullptr, nullptr, (const bf16_t*)(ws + OFF_HN), (const bf16_t*)(ws + OFF_W + W_WIN) + ((size_t)l * PL + 2560) * D, (bf16_t*)(ws + OFF_C));
        }
        GSYNC();
        { PH unsigned char* ws = KWS; const bf16_t* PROJ = (const bf16_t*)(ws + OFF_C); bf16_t* CAT = (bf16_t*)(ws + OFF_D);
          const float* gw = KIN(6) + l * 16 * 192; const float* gb = KIN(7) + l * 192; float* GSUM = (float*)(ws + OFF_E + E_UPD); const float* gng = KIN(8) + l * 96;
          for (int u = bx; u < 256; u += G) gla3_unit<true>(u, tid, lds, PROJ, gw, gb, gng, GSUM, CAT);
          __syncthreads(); }
        { PH unsigned char* ws = KWS; const bf16_t* PROJ = (const bf16_t*)(ws + OFF_C); bf16_t* CAT = (bf16_t*)(ws + OFF_D);
          const float *are = (const float*)(ws + OFF_TOK) + (size_t)l * 1536 * 4, *aim = nullptr, *lst = nullptr,        *bre = KIN(13) + l * 24576, *bim = KIN(14) + l * 24576;
          const float *cre = KIN(15) + l * 24576, *cim = KIN(16) + l * 24576, *sd = KIN(17) + l * 384;
          float* S5E = (float*)(ws + OFF_E + E_S5E); const float *glb = KIN(19) + l * 384, *sng = KIN(20) + l * 384; const bf16_t* GLUT = (const bf16_t*)(ws + OFF_W + W_GLU) + (size_t)l * 384 * 384;
          for (int u = bx; u < 256; u += G) s5_unit<true>(u, tid, lds, PROJ, are, aim, lst, bre, bim, cre, cim, sd, S5E, GLUT, glb, sng, CAT);
          __syncthreads(); }
        { PH unsigned char* ws = KWS; const bf16_t* PROJ = (const bf16_t*)(ws + OFF_C);
          unsigned long long* MASK = (unsigned long long*)(ws + OFF_E + E_MASK);
          const bf16_t* IKC = (const bf16_t*)(ws + OFF_E + E_IKC);
          const bool serp = ((T / 8) % G) == 0;
          __syncthreads();
          tk5_prefetch(bx, lds, PROJ, tid);
          for (int vb = bx, rnd = 0; vb < T / 8; vb += G, ++rnd) {
              int tid_u; asm volatile("v_mbcnt_lo_u32_b32 %0, -1, 0\n\tv_mbcnt_hi_u32_b32 %0, -1, %0\n\tv_lshl_add_u32 %0, %1, 6, %0" : "=&v"(tid_u) : "s"(wave_s));
              const int uu = (serp && (rnd & 1)) ? rnd * G + (G - 1 - bx) : vb;
              const int vn = vb + G, un = vn < T / 8 ? ((serp && ((rnd + 1) & 1)) ? (rnd + 1) * G + (G - 1 - bx) : vn) : -1;
              topk5_unit(uu, un, lds, PROJ, IKC, MASK, tid_u); } }
        GSYNC();
        { PH unsigned char* ws = KWS; const bf16_t* PROJ = (const bf16_t*)(ws + OFF_C); bf16_t* CAT = (bf16_t*)(ws + OFF_D);
          __syncthreads();
          { const unsigned long long* MASK = (const unsigned long long*)(ws + OFF_E + E_MASK); const float* dng = KIN(9) + l * 256;
            for (int pi0 = bx; pi0 < 256; pi0 += G) {
                const int pi = (G == 256) ? ((pi0 & 7) >> 1) * 64 + (pi0 & 1) * 32 + (pi0 >> 3) : pi0;
                const int bb = pi >> 6, jq = pi & 63;
                dsa_attn_unit(bb, 127 - jq, lds, PROJ, MASK, dng, CAT, tid);
                dsa_attn_unit(bb, jq, lds, PROJ, MASK, dng, CAT, tid); } }
        }
        GSYNC();
        { PH unsigned char* ws = KWS;
          pg8::Gemm g; g.A = (bf16_t*)(ws + OFF_D); g.Bt = (bf16_t*)(ws + OFF_W + W_WOUT) + (size_t)l * D * D; g.M = T; g.N = D; g.K = D; pg8::StaticOrder S; S.init(T, D, G, bx);
          EpiRes E; E.xin = (l == 0) ? KIN(0) : KOUT; E.xout = KOUT; E.gt = (const float*)(ws + OFF_MOD) + (size_t)l * 4 * 6144 + 2048;
          pg8::gemm_phase<EpiRes, pg8::StaticOrder, true, true>(lds, g, S, E, tid); }
        GSYNC();
        { PH unsigned char* ws = KWS; const float* X = KOUT; const float* modl = (const float*)(ws + OFF_MOD) + (size_t)l * 4 * 6144;
          const float *n2g = KIN(22) + l * D, *rgw = KIN(23) + l * 4096, *rgb = KIN(24) + l * 4, *rew = KIN(25) + l * 32768, *reb = KIN(26) + l * 32;
          ph_norm2_router(lds, X, n2g, modl, rgw, rgb, rew, reb, (bf16_t*)(ws + OFF_HN), (unsigned*)(ws + OFF_CNT), (int*)(ws + OFF_C), (int*)(ws + OFF_EID), (float*)(ws + OFF_EW), (int*)(ws + OFF_SLOT), tid, bx, G); }
        GSYNC();
        { PH unsigned char* ws = KWS;
          pg8::Gemm g; moe_plan((LAS unsigned*)(lds + MOE_PLAN), (const unsigned*)(ws + OFF_CNT), tid);
          g.A = (bf16_t*)(ws + OFF_HN); g.tok = (const int*)(ws + OFF_C); g.Bt = (bf16_t*)(ws + OFF_W + W_EGU); g.M = MAXTILES * 256; g.N = 1024; g.K = 1024; MoeOrder S; S.plan = (const LAS unsigned*)(lds + MOE_PLAN); S.nN = 4; S.estride = (long)1024 * 1024 * 2; S.init(G, bx);
          EpiGU E; E.HID = (bf16_t*)(ws + OFF_E);
          pg8::gemm_phase<EpiGU, MoeOrder, true, true, true>(lds, g, S, E, tid); }
        GSYNC();
        { PH unsigned char* ws = KWS;
          pg8::Gemm g; moe_plan((LAS unsigned*)(lds + MOE_PLAN), (const unsigned*)(ws + OFF_CNT), tid);
          g.A = (bf16_t*)(ws + OFF_E); g.Bt = (bf16_t*)(ws + OFF_W + W_EDN); g.M = MAXTILES * 256; g.N = 1024; g.K = 512; MoeOrder S; S.plan = (const LAS unsigned*)(lds + MOE_PLAN); S.nN = 4; S.estride = (long)1024 * 512 * 2; S.init(G, bx);
          pg8::EpiBf16<0> E; E.O = (bf16_t*)(ws + OFF_D); E.ldc = 1024; E.bias = nullptr; E.split_cols = 0; E.split_stride = 0; E.scale0 = 1.f;
          pg8::gemm_phase<pg8::EpiBf16<0>, MoeOrder, true, true>(lds, g, S, E, tid); }
        GSYNC();
        if (l == 0) {
            { PH unsigned char* ws = KWS;
              moe_plan((LAS unsigned*)(lds + MOE_PLAN), (const unsigned*)(ws + OFF_CNT), tid);
              ph_moe_combine<false>((const LAS unsigned*)(lds + MOE_PLAN), KOUT, (const bf16_t*)(ws + OFF_D), (const int*)(ws + OFF_EID), (const int*)(ws + OFF_SLOT), (const float*)(ws + OFF_EW), (const float*)(ws + OFF_MOD), KIN(4) + D, (const float*)(ws + OFF_MOD) + 4 * 6144, (bf16_t*)(ws + OFF_HN), tid, bx, G); }
            { PH ProArgs pa; pa.c = nullptr; pa.ada_w = nullptr; pa.ada_b = nullptr; pa.w_in = nullptr; pa.w_out = nullptr; pa.glu_w = nullptr;
              pa.wgate = KIN(27) + (size_t)32 * 1024 * 512; pa.wup = KIN(28) + (size_t)32 * 1024 * 512; pa.wdown = KIN(29) + (size_t)32 * 512 * 1024; pa.ws = KWS; pa.do_small = 0; pa.pad = 0;
              ph_prologue(pa, lds, tid, bx, G); }
            GSYNC();
        } else {
            PH unsigned char* ws = KWS;
            moe_plan((LAS unsigned*)(lds + MOE_PLAN), (const unsigned*)(ws + OFF_CNT), tid);
            ph_moe_combine<true>((const LAS unsigned*)(lds + MOE_PLAN), KOUT, (const bf16_t*)(ws + OFF_D), (const int*)(ws + OFF_EID), (const int*)(ws + OFF_SLOT), (const float*)(ws + OFF_EW), (const float*)(ws + OFF_MOD) + 4 * 6144, KIN(30), nullptr, nullptr, tid, bx, G);
        }
    }
}
}

extern "C" void kernel_launch(void* const* d_in, const int* in_sizes, int n_in, void* d_out, int out_size, void* d_ws, size_t ws_size, hipStream_t stream) {
    static int grid_blocks = 0;
    if (grid_blocks == 0) {
        if (n_in != 31 || in_sizes[0] != T * D || out_size != T * D || ws_size < WS_NEED) { fprintf(stderr, "kernel_launch: unexpected shapes / workspace (%d inputs, ws %zu need %zu)\n", n_in, ws_size, (size_t)WS_NEED); grid_blocks = -1; return; }
        int dev = 0, cus = 0, per_cu = 0;
        if (hipGetDevice(&dev) != hipSuccess || hipDeviceGetAttribute(&cus, hipDeviceAttributeMultiprocessorCount, dev) != hipSuccess) { grid_blocks = -1; return; }
        if (hipFuncSetAttribute((const void*)k_mega, hipFuncAttributeMaxDynamicSharedMemorySize, LDS_BYTES) != hipSuccess) { fprintf(stderr, "hipFuncSetAttribute failed\n"); grid_blocks = -1; return; }
        if (hipOccupancyMaxActiveBlocksPerMultiprocessor(&per_cu, (const void*)k_mega, 512, LDS_BYTES) != hipSuccess || per_cu < 1) { fprintf(stderr, "occupancy query: %d blocks per CU\n", per_cu); grid_blocks = -1; return; }
        grid_blocks = cus;
    }
    if (grid_blocks < 0) return;
    if (hipMemsetAsync((char*)d_ws + OFF_CTL, 0, 16384, stream) != hipSuccess) { fprintf(stderr, "hipMemsetAsync failed\n"); return; }
    Params p; memset((void*)&p, 0, sizeof(p));
    for (int i = 0; i < 31; ++i) p.in[i] = (const float*)d_in[i];
    p.out = (float*)d_out; p.ws = (unsigned char*)d_ws;
    void* args[] = {&p};
    hipError_t e = hipLaunchCooperativeKernel((const void*)k_mega, dim3(grid_blocks), dim3(512), args, LDS_BYTES, stream);
    if (e != hipSuccess) fprintf(stderr, "cooperative launch failed: %s (grid %d)\n", hipGetErrorString(e), grid_blocks);
}
```
